# Optimizing an MI355X kernel written in HIP

```python
import math
import jax, jax.numpy as jnp
from jax import lax
import numpy as np

D_MODEL = 2048
BATCH = 1
SEQ = 8192
DEPTH = 2

GRID_W = 64
CTX_LEN = 256
Q_BLOCK = 128
ROPE_THETA = 10000.0
NORM_EPS = 1e-6

N_HEADS_A = 8
N_KV_HEADS_A = 2
HEAD_DIM_A = 128
N_HEADS_B = 4
HEAD_DIM_B = 64
VALUE_DIM_B = 2 * HEAD_DIM_B
N_FOURIER_GROUPS = 4
FOURIER_GROUP_DIM = 128

WIDTH_A = N_HEADS_A * HEAD_DIM_A
WIDTH_B = N_HEADS_B * VALUE_DIM_B
WIDTH_C = N_FOURIER_GROUPS * FOURIER_GROUP_DIM
MIX_WIDTH = WIDTH_A + WIDTH_B + WIDTH_C

QA_COLS = N_HEADS_A * HEAD_DIM_A
QB_COLS = N_HEADS_B * 2 * HEAD_DIM_B
C_COLS = WIDTH_C
KA_COLS = N_KV_HEADS_A * HEAD_DIM_A
VA_COLS = N_KV_HEADS_A * HEAD_DIM_A
KB_COLS = N_HEADS_B * 2 * HEAD_DIM_B
VB_COLS = N_HEADS_B * VALUE_DIM_B
KV_START = QA_COLS + QB_COLS + C_COLS
IN_COLS = KV_START + KA_COLS + VA_COLS + KB_COLS + VB_COLS

D_FF = 7168
N_EXPERTS = 8
TOP_K = 2
D_FF_EXPERT = 7168
N_DENSE = (DEPTH + 1) // 2
N_MOE = DEPTH // 2
N_MOD = 6

kernel_name = 'hybrid_dit_gqa_diffattn_fourier_moe'


def _rmsnorm(x, g):
    xf = x.astype(jnp.float32)
    y = xf * lax.rsqrt(jnp.mean(xf * xf, axis=-1, keepdims=True) + NORM_EPS)
    return (y * g.astype(jnp.float32)).astype(x.dtype)


def _modulate(h, shift, scale):
    return h * (1 + scale) + shift


def _axial_rope_tables(n_rows, head_dim):
    rows = jnp.repeat(jnp.arange(n_rows), GRID_W).astype(jnp.float32)
    cols = jnp.tile(jnp.arange(GRID_W), n_rows).astype(jnp.float32)
    axis_dim = head_dim // 2
    freqs = ROPE_THETA ** (-jnp.arange(0, axis_dim, 2, dtype=jnp.float32) / axis_dim)
    row_ang = rows[:, None] * freqs
    col_ang = cols[:, None] * freqs
    return (jnp.cos(row_ang), jnp.sin(row_ang), jnp.cos(col_ang), jnp.sin(col_ang))


def _rotate(x, cos, sin):
    x1, x2 = jnp.split(x, 2, axis=-1)
    return jnp.concatenate([x1 * cos - x2 * sin, x2 * cos + x1 * sin], axis=-1)


def _apply_axial_rope(x, tables):
    bshape = (1, x.shape[1]) + (1,) * (x.ndim - 3) + (tables[0].shape[-1],)
    rc, rs, cc, cs = (t.reshape(bshape) for t in tables)
    x_row, x_col = jnp.split(x.astype(jnp.float32), 2, axis=-1)
    out = jnp.concatenate([_rotate(x_row, rc, rs), _rotate(x_col, cc, cs)], axis=-1)
    return out.astype(x.dtype)


def _sweep_query_blocks(fn, q):
    b, n = q.shape[:2]
    nb = n // Q_BLOCK
    qb = jnp.swapaxes(q.reshape((b, nb, Q_BLOCK) + q.shape[2:]), 0, 1)
    out = lax.map(fn, qb)
    return jnp.swapaxes(out, 0, 1).reshape((b, n) + out.shape[3:])


def _gqa_attention(q, k, v):
    b, n = q.shape[:2]
    q = q.reshape(b, n, N_KV_HEADS_A, N_HEADS_A // N_KV_HEADS_A, HEAD_DIM_A)
    scale = HEAD_DIM_A ** -0.5

    def block(qb):
        s = jnp.einsum('bqhgd,bkhd->bhgqk', qb, k, preferred_element_type=jnp.float32) * scale
        p = jax.nn.softmax(s, axis=-1).astype(v.dtype)
        return jnp.einsum('bhgqk,bkhd->bqhgd', p, v)

    return _sweep_query_blocks(block, q).reshape(b, n, WIDTH_A)


def _diff_attention(q, k, v, lam, g_subln, lambda_init):
    b, n = q.shape[:2]
    scale = HEAD_DIM_B ** -0.5
    k1, k2 = k[..., 0, :], k[..., 1, :]

    def block(qb):
        s1 = jnp.einsum('bqhd,bkhd->bhqk', qb[..., 0, :], k1, preferred_element_type=jnp.float32) * scale
        s2 = jnp.einsum('bqhd,bkhd->bhqk', qb[..., 1, :], k2, preferred_element_type=jnp.float32) * scale
        p = jax.nn.softmax(s1, axis=-1) - lam * jax.nn.softmax(s2, axis=-1)
        return jnp.einsum('bhqk,bkhe->bqhe', p.astype(v.dtype), v)

    out = _sweep_query_blocks(block, q)
    out = _rmsnorm(out, g_subln) * (1.0 - lambda_init)
    return out.reshape(b, n, WIDTH_B)


def _fourier_mix(u, w_fourier):
    b, n = u.shape[:2]
    ug = u.reshape(b, n, N_FOURIER_GROUPS, FOURIER_GROUP_DIM).astype(jnp.float32)
    f = jnp.fft.fftn(ug, axes=(1, 3), norm='ortho').real.astype(u.dtype)
    return jnp.einsum('bngc,gcd->bngd', f, w_fourier).reshape(b, n, WIDTH_C)


def _split_queries(p_q, g_q_a):
    b, n = p_q.shape[:2]
    qa = _rmsnorm(p_q[..., :QA_COLS].reshape(b, n, N_HEADS_A, HEAD_DIM_A), g_q_a)
    qb = p_q[..., QA_COLS:QA_COLS + QB_COLS].reshape(b, n, N_HEADS_B, 2, HEAD_DIM_B)
    u = p_q[..., QA_COLS + QB_COLS:]
    return qa, qb, u


def _split_keys_values(p_kv, g_k_a):
    b, m = p_kv.shape[:2]
    o1 = KA_COLS
    o2 = o1 + VA_COLS
    o3 = o2 + KB_COLS
    ka = _rmsnorm(p_kv[..., :o1].reshape(b, m, N_KV_HEADS_A, HEAD_DIM_A), g_k_a)
    va = p_kv[..., o1:o2].reshape(b, m, N_KV_HEADS_A, HEAD_DIM_A)
    kb = p_kv[..., o2:o3].reshape(b, m, N_HEADS_B, 2, HEAD_DIM_B)
    vb = p_kv[..., o3:].reshape(b, m, N_HEADS_B, VALUE_DIM_B)
    return ka, va, kb, vb


def _mix_head_groups(qa, qb, u, ka, va, kb, vb, lam, g_subln, lambda_init, w_fourier, w_out):
    y = jnp.concatenate([
        _gqa_attention(qa, ka, va),
        _diff_attention(qb, kb, vb, lam, g_subln, lambda_init),
        _fourier_mix(u, w_fourier),
    ], axis=-1)
    return y @ w_out


def _token_mixer(h_lat, h_ctx, w_in, g_q_a, g_k_a, lam, g_subln, lambda_init,
                 w_fourier, w_out, rope_a, rope_b, with_ctx_out):
    if with_ctx_out:
        p_ctx = h_ctx @ w_in
        kv_ctx = p_ctx[..., KV_START:]
    else:
        kv_ctx = h_ctx @ w_in[:, KV_START:]
    ka_c, va_c, kb_c, vb_c = _split_keys_values(kv_ctx, g_k_a)

    p_lat = h_lat @ w_in
    qa_l, qb_l, u_l = _split_queries(p_lat[..., :KV_START], g_q_a)
    ka_l, va_l, kb_l, vb_l = _split_keys_values(p_lat[..., KV_START:], g_k_a)
    qa_l = _apply_axial_rope(qa_l, rope_a)
    ka_l = _apply_axial_rope(ka_l, rope_a)
    qb_l = _apply_axial_rope(qb_l, rope_b)
    kb_l = _apply_axial_rope(kb_l, rope_b)

    def cat(a, b):
        return jnp.concatenate([a, b], axis=1)

    y_lat = _mix_head_groups(qa_l, qb_l, u_l, cat(ka_l, ka_c), cat(va_l, va_c),
                             cat(kb_l, kb_c), cat(vb_l, vb_c), lam, g_subln,
                             lambda_init, w_fourier, w_out)
    y_ctx = None
    if with_ctx_out:
        qa_c, qb_c, u_c = _split_queries(p_ctx[..., :KV_START], g_q_a)
        y_ctx = _mix_head_groups(qa_c, qb_c, u_c, ka_c, va_c, kb_c, vb_c, lam, g_subln,
                                 lambda_init, w_fourier, w_out)
    return y_lat, y_ctx


def _swiglu(h, w_gate, w_up, w_down):
    return (jax.nn.silu(h @ w_gate) * (h @ w_up)) @ w_down


def _moe_swiglu(h, w_router, w_gate, w_up, w_down):
    logits = jnp.einsum('bnd,de->bne', h, w_router, preferred_element_type=jnp.float32)
    top_logits, top_idx = lax.top_k(logits, TOP_K)
    top_w = jax.nn.softmax(top_logits, axis=-1)
    combine = jnp.sum(jax.nn.one_hot(top_idx, N_EXPERTS, dtype=jnp.float32) * top_w[..., None],
                      axis=-2).astype(h.dtype)
    out = jnp.zeros_like(h)
    for e in range(N_EXPERTS):
        out = out + combine[..., e:e + 1] * _swiglu(h, w_gate[e], w_up[e], w_down[e])
    return out


def _channel_mixer(h, layer, w_gate_dense, w_up_dense, w_down_dense,
                   w_router, w_gate_moe, w_up_moe, w_down_moe):
    j = layer // 2
    if layer % 2 == 0:
        return _swiglu(h, w_gate_dense[j], w_up_dense[j], w_down_dense[j])
    return _moe_swiglu(h, w_router[j], w_gate_moe[j], w_up_moe[j], w_down_moe[j])


def setup_inputs(seed: int = 0) -> dict:
    key = jax.random.key(seed)
    ks = iter(jax.random.split(key, 32))

    def normal(shape, scale):
        return jax.random.normal(next(ks), shape, jnp.float32) * scale

    def gain(shape):
        return 1.0 + 0.05 * jax.random.normal(next(ks), shape, jnp.float32)

    d = D_MODEL
    return {
        'x': normal((BATCH, SEQ, d), 1.0),
        'c': normal((BATCH, d), 1.0),
        'ctx': normal((BATCH, CTX_LEN, d), 1.0),
        'c_ctx': normal((d,), 1.0),
        'w_mod': normal((DEPTH, d, N_MOD * d), 0.5 * d ** -0.5),
        'b_mod': normal((DEPTH, N_MOD * d), 0.01),
        'g_pre_mix': gain((DEPTH, d)),
        'g_post_mix': gain((DEPTH, d)),
        'g_pre_ffn': gain((DEPTH, d)),
        'g_post_ffn': gain((DEPTH, d)),
        'w_in': normal((DEPTH, d, IN_COLS), d ** -0.5),
        'g_q_a': gain((DEPTH, HEAD_DIM_A)),
        'g_k_a': gain((DEPTH, HEAD_DIM_A)),
        'lambda_q1': normal((DEPTH, HEAD_DIM_B), 0.1),
        'lambda_k1': normal((DEPTH, HEAD_DIM_B), 0.1),
        'lambda_q2': normal((DEPTH, HEAD_DIM_B), 0.1),
        'lambda_k2': normal((DEPTH, HEAD_DIM_B), 0.1),
        'g_subln_b': gain((DEPTH, VALUE_DIM_B)),
        'w_fourier': normal((DEPTH, N_FOURIER_GROUPS, FOURIER_GROUP_DIM, FOURIER_GROUP_DIM),
                            FOURIER_GROUP_DIM ** -0.5),
        'w_out': normal((DEPTH, MIX_WIDTH, d), MIX_WIDTH ** -0.5),
        'w_gate_dense': normal((N_DENSE, d, D_FF), d ** -0.5),
        'w_up_dense': normal((N_DENSE, d, D_FF), d ** -0.5),
        'w_down_dense': normal((N_DENSE, D_FF, d), D_FF ** -0.5),
        'w_router': normal((N_MOE, d, N_EXPERTS), d ** -0.5),
        'w_gate_moe': normal((N_MOE, N_EXPERTS, d, D_FF_EXPERT), d ** -0.5),
        'w_up_moe': normal((N_MOE, N_EXPERTS, d, D_FF_EXPERT), d ** -0.5),
        'w_down_moe': normal((N_MOE, N_EXPERTS, D_FF_EXPERT, d), D_FF_EXPERT ** -0.5),
    }


def reference(x, c, ctx, c_ctx, w_mod, b_mod, g_pre_mix, g_post_mix, g_pre_ffn, g_post_ffn,
              w_in, g_q_a, g_k_a, lambda_q1, lambda_k1, lambda_q2, lambda_k2, g_subln_b,
              w_fourier, w_out, w_gate_dense, w_up_dense, w_down_dense, w_router,
              w_gate_moe, w_up_moe, w_down_moe):
    n_lat = x.shape[1]
    ROWS = n_lat // GRID_W
    rope_a = _axial_rope_tables(ROWS, HEAD_DIM_A)
    rope_b = _axial_rope_tables(ROWS, HEAD_DIM_B)
    cond_lat = jax.nn.silu(c)[:, None, :]
    cond_ctx = jax.nn.silu(c_ctx)[None, None, :]
    x_lat, x_ctx = x, ctx
    for layer in range(DEPTH):
        last = layer == DEPTH - 1
        sh_m, sc_m, gt_m, sh_f, sc_f, gt_f = jnp.split(cond_lat @ w_mod[layer] + b_mod[layer], N_MOD, axis=-1)
        csh_m, csc_m, cgt_m, csh_f, csc_f, cgt_f = jnp.split(cond_ctx @ w_mod[layer] + b_mod[layer], N_MOD, axis=-1)
        lambda_init = 0.8 - 0.6 * math.exp(-0.3 * layer)
        lam = (jnp.exp(jnp.sum(lambda_q1[layer].astype(jnp.float32) * lambda_k1[layer].astype(jnp.float32)))
               - jnp.exp(jnp.sum(lambda_q2[layer].astype(jnp.float32) * lambda_k2[layer].astype(jnp.float32)))
               + lambda_init)

        h_lat = _modulate(_rmsnorm(x_lat, g_pre_mix[layer]), sh_m, sc_m)
        h_ctx = _modulate(_rmsnorm(x_ctx, g_pre_mix[layer]), csh_m, csc_m)
        y_lat, y_ctx = _token_mixer(h_lat, h_ctx, w_in[layer], g_q_a[layer], g_k_a[layer], lam,
                                    g_subln_b[layer], lambda_init, w_fourier[layer], w_out[layer],
                                    rope_a, rope_b, not last)
        x_lat = x_lat + gt_m * _rmsnorm(y_lat, g_post_mix[layer])
        if not last:
            x_ctx = x_ctx + cgt_m * _rmsnorm(y_ctx, g_post_mix[layer])

        h_lat = _modulate(_rmsnorm(x_lat, g_pre_ffn[layer]), sh_f, sc_f)
        f_lat = _channel_mixer(h_lat, layer, w_gate_dense, w_up_dense, w_down_dense,
                               w_router, w_gate_moe, w_up_moe, w_down_moe)
        x_lat = x_lat + gt_f * _rmsnorm(f_lat, g_post_ffn[layer])
        if not last:
            h_ctx = _modulate(_rmsnorm(x_ctx, g_pre_ffn[layer]), csh_f, csc_f)
            f_ctx = _channel_mixer(h_ctx, layer, w_gate_dense, w_up_dense, w_down_dense,
                                   w_router, w_gate_moe, w_up_moe, w_down_moe)
            x_ctx = x_ctx + cgt_f * _rmsnorm(f_ctx, g_post_ffn[layer])
    return x_lat
```

```cpp
#include <hip/hip_runtime.h>
#include <hip/hip_bf16.h>
#include <cstdio>
#include <cstdint>
#include <cmath>
namespace pg8 {
#define PG8_LAS __attribute__((address_space(3)))
typedef unsigned short bf16_t;
typedef short bf16x8 __attribute__((ext_vector_type(8)));
typedef float f32x4 __attribute__((ext_vector_type(4)));
typedef unsigned u32x4 __attribute__((ext_vector_type(4)));
constexpr int BM = 256, BK = 64, HALF = 128, HTB = HALF * BK * 2, STAGE_BYTES = 8 * HTB, NXCD = 8, WGM = 8;

__host__ __device__ __forceinline__ int lds_byte(int r, int c) { const int st = (r >> 4) * 2 + (c >> 5), rr = r & 15, cc = c & 31, ob = rr * 64 + cc * 2; return st * 1024 + (ob ^ (((ob >> 9) & 1) << 5)); }
__host__ __device__ __forceinline__ void stage_rc(int b, int& R, int& C) { const int st = b / 1024, sb = b % 1024, swz = sb ^ (((sb >> 9) & 1) << 5); R = (st >> 1) * 16 + swz / 64; C = (st & 1) * 32 + (swz % 64) / 2; }
__host__ __device__ __forceinline__ int perm32(int rho) { const int n = rho >> 4, i = rho & 15; return 8 * (i >> 2) + 4 * n + (i & 3); }

struct Unit { long aoff, boff; int orow, ocol, sel; };
struct Gemm { const bf16_t* A; const bf16_t* Bt; int lda, ldb, K; };

typedef float f32x2_t __attribute__((ext_vector_type(2))); typedef __bf16 bf16x2_t __attribute__((ext_vector_type(2)));
__device__ __forceinline__ unsigned cvt_pk_bf16(float lo, float hi) { f32x2_t v = {lo, hi}; bf16x2_t b = __builtin_convertvector(v, bf16x2_t); return __builtin_bit_cast(unsigned, b); }

template <bool XSW> __device__ __forceinline__ f32x4 xsw4(f32x4 v, int fq) {
    if (!XSW) return v; const bool o = (fq & 1) != 0; return (f32x4){o ? v[1] : v[0], o ? v[0] : v[1], o ? v[3] : v[2], o ? v[2] : v[3]}; }
template <bool XSW = false> struct EpiBf16T {
    static constexpr bool PERM = true;
    bf16_t* O0; int ldc0; bf16_t* O1; int ldc1;
    template <class UU> __device__ __forceinline__ void operator()(const f32x4 (&acc)[2][2][4][2], const UU& u, int wr, int wc, int fr, int fq) const {
        bf16_t* O = u.sel ? O1 : O0; const int ldc = u.sel ? ldc1 : ldc0;
        const int row0 = u.orow + wr * 64 + fr, col0 = u.ocol + wc * 32 + 8 * fq;
#pragma unroll
        for (int ai = 0; ai < 2; ++ai)
#pragma unroll
            for (int m = 0; m < 4; ++m) { bf16_t* rowp = O + (size_t)(row0 + ai * HALF + m * 16) * ldc + col0;
#pragma unroll
                for (int bj = 0; bj < 2; ++bj) { const f32x4 v0 = xsw4<XSW>(acc[ai][bj][m][0], fq), v1 = xsw4<XSW>(acc[ai][bj][m][1], fq);
                    u32x4 w; w.x = cvt_pk_bf16(v0[0], v0[1]); w.y = cvt_pk_bf16(v0[2], v0[3]); w.z = cvt_pk_bf16(v1[0], v1[1]); w.w = cvt_pk_bf16(v1[2], v1[3]);
                    *(u32x4*)(rowp + bj * HALF) = w; } }
    }
};
typedef EpiBf16T<false> EpiBf16;
__device__ __forceinline__ float silu_mul(float g, float u) { return g * u * __builtin_amdgcn_rcpf(1.0f + __builtin_amdgcn_exp2f(-1.4426950408889634f * g)); }
template <bool XSW = false> struct EpiSwigluT {
    static constexpr bool PERM = true;
    bf16_t* O; int ldc;
    template <class UU> __device__ __forceinline__ void operator()(const f32x4 (&acc)[2][2][4][2], const UU& u, int wr, int wc, int fr, int fq) const {
        const int row0 = u.orow + wr * 64 + fr, col0 = u.ocol + wc * 32 + 8 * fq;
#pragma unroll
        for (int ai = 0; ai < 2; ++ai)
#pragma unroll
            for (int m = 0; m < 4; ++m) { bf16_t* rowp = O + (size_t)(row0 + ai * HALF + m * 16) * ldc + col0;
                const f32x4 g0 = xsw4<XSW>(acc[ai][0][m][0], fq), g1 = xsw4<XSW>(acc[ai][0][m][1], fq), u0 = xsw4<XSW>(acc[ai][1][m][0], fq), u1 = xsw4<XSW>(acc[ai][1][m][1], fq);
                u32x4 w; w.x = cvt_pk_bf16(silu_mul(g0[0], u0[0]), silu_mul(g0[1], u0[1])); w.y = cvt_pk_bf16(silu_mul(g0[2], u0[2]), silu_mul(g0[3], u0[3]));
                w.z = cvt_pk_bf16(silu_mul(g1[0], u1[0]), silu_mul(g1[1], u1[1])); w.w = cvt_pk_bf16(silu_mul(g1[2], u1[2]), silu_mul(g1[3], u1[3]));
                *(u32x4*)rowp = w; }
    }
};
typedef EpiSwigluT<false> EpiSwiglu;
struct EpiF32 {
    static constexpr bool PERM = false;
    float* O; int ldc;
    template <class UU> __device__ __forceinline__ void operator()(const f32x4 (&acc)[2][2][4][2], const UU& u, int wr, int wc, int fr, int fq) const {
        const int row0 = u.orow + wr * 64 + fr, col0 = u.ocol + wc * 32 + 4 * fq;
#pragma unroll
        for (int ai = 0; ai < 2; ++ai)
#pragma unroll
            for (int m = 0; m < 4; ++m) { float* rowp = O + (size_t)(row0 + ai * HALF + m * 16) * ldc + col0;
#pragma unroll
                for (int bj = 0; bj < 2; ++bj)
#pragma unroll
                    for (int n = 0; n < 2; ++n) *(f32x4*)(rowp + bj * HALF + n * 16) = acc[ai][bj][m][n]; }
    }
};

template <class Epi, class Sched, bool ALIGN_EPI, bool KBLK = false>
__device__ __forceinline__ void gemm_phase(PG8_LAS unsigned char* lds, const Gemm g, const Sched& S, const Epi& E) {
    int tid_ = threadIdx.x; asm volatile("" : "+v"(tid_));
    const int tid = tid_, wid = __builtin_amdgcn_readfirstlane(tid >> 6), lane = tid & 63, wr = wid >> 2, wc = wid & 3, fr = lane & 15, fq = lane >> 4;
    const int K = g.K, nt = K / BK;
    unsigned voffA[2], voffB[2];
#pragma unroll
    for (int i = 0; i < 2; ++i) { int R, C; stage_rc(tid * 16 + i * 8192, R, C); const int Rb = Epi::PERM ? ((R & ~31) + perm32(R & 31)) : R;
        voffA[i] = (unsigned)(R * g.lda + C) * 2u; voffB[i] = KBLK ? (unsigned)((C >> 3) * g.ldb + Rb) * 16u : (unsigned)(Rb * g.ldb + C) * 2u; }
    const size_t kstep = (size_t)(BK * 2);
    const size_t hstepA = (size_t)HALF * g.lda * 2, hstepB = KBLK ? (size_t)HALF * 16 : (size_t)HALF * g.ldb * 2;
    const size_t kstepB = KBLK ? (size_t)8 * g.ldb * 16 : kstep;
    const unsigned ldsw = (unsigned)wid * 1024u;
    const int aoff = lds_byte(wr * 64 + fr, fq * 8), boff = lds_byte(wc * 32 + fr, fq * 8);
#define PG8_SA(b, h) (((b) * 2 + (h)) * HTB)
#define PG8_SB(b, h) ((4 + (b) * 2 + (h)) * HTB)
#define PG8_STAGE(bufoff, gbase, voff) do { _Pragma("unroll") for (int _i = 0; _i < 2; ++_i) \
        __builtin_amdgcn_global_load_lds((const unsigned*)((const char*)(gbase) + (voff)[_i]), (PG8_LAS unsigned*)(lds + (bufoff) + ldsw + _i * 8192), 16, 0, 0); } while (0)
#define PG8_LDA(dst, b, h) do { _Pragma("unroll") for (int m = 0; m < 4; ++m) _Pragma("unroll") for (int k = 0; k < 2; ++k) dst[m][k] = *(const PG8_LAS bf16x8*)(lds + PG8_SA(b, h) + aoff + m * 2048 + k * 1024); } while (0)
#define PG8_LDB(dst, b, h) do { _Pragma("unroll") for (int n = 0; n < 2; ++n) _Pragma("unroll") for (int k = 0; k < 2; ++k) dst[n][k] = *(const PG8_LAS bf16x8*)(lds + PG8_SB(b, h) + boff + n * 2048 + k * 1024); } while (0)
#define PG8_MMA(ai, bj, At, Bt) do { __builtin_amdgcn_s_setprio(1); _Pragma("unroll") for (int m = 0; m < 4; ++m) _Pragma("unroll") for (int n = 0; n < 2; ++n) _Pragma("unroll") for (int k = 0; k < 2; ++k) \
        acc[ai][bj][m][n] = __builtin_amdgcn_mfma_f32_16x16x32_bf16(Bt[n][k], At[m][k], acc[ai][bj][m][n], 0, 0, 0); __builtin_amdgcn_s_setprio(0); } while (0)
#define PG8_WAIT_V(n) asm volatile("s_waitcnt vmcnt(" #n ")" ::: "memory")
#define PG8_WAIT_L(n) asm volatile("s_waitcnt lgkmcnt(" #n ")" ::: "memory")
#define PG8_BAR __builtin_amdgcn_s_barrier()
#define PG8_SCHED __builtin_amdgcn_sched_barrier(0)
    Unit cur, nxt; int ui = 0;
    if (!S.next(0, cur)) return;
    f32x4 acc[2][2][4][2];
#pragma unroll
    for (int a = 0; a < 2; ++a)
#pragma unroll
        for (int b = 0; b < 2; ++b)
#pragma unroll
            for (int m = 0; m < 4; ++m)
#pragma unroll
                for (int n = 0; n < 2; ++n) acc[a][b][m][n] = (f32x4){0.f, 0.f, 0.f, 0.f};
    bf16x8 At[4][2], B0[2][2], B1[2][2];
    const char* cA = (const char*)g.A + (size_t)cur.aoff * 2; const char* cB = (const char*)g.Bt + (size_t)cur.boff * 2;
    PG8_STAGE(PG8_SB(0, 0), cB, voffB); PG8_STAGE(PG8_SB(0, 1), cB + hstepB, voffB); PG8_STAGE(PG8_SA(0, 0), cA, voffA); PG8_STAGE(PG8_SA(0, 1), cA + hstepA, voffA);
    if (wr == 1) PG8_BAR;
    PG8_WAIT_V(2); PG8_BAR;
    PG8_STAGE(PG8_SB(1, 0), cB + kstepB, voffB); PG8_STAGE(PG8_SA(1, 0), cA + kstep, voffA); PG8_STAGE(PG8_SB(1, 1), cB + hstepB + kstepB, voffB);
    PG8_WAIT_V(6); PG8_BAR;
    for (;;) {
        const bool has_next = S.next(ui + 1, nxt);
        const char* nA = has_next ? (const char*)g.A + (size_t)nxt.aoff * 2 : cA; const char* nB = has_next ? (const char*)g.Bt + (size_t)nxt.boff * 2 : cB;
        for (int t = 0; t < nt; t += 2) {
            const bool last = (t == nt - 2);
            const char* a1 = cA + (size_t)(t + 1) * kstep;
            const char* a2 = last ? nA : cA + (size_t)(t + 2) * kstep; const char* b2 = last ? nB : cB + (size_t)(t + 2) * kstepB;
            const char* a3 = a2 + kstep; const char* b3 = b2 + kstepB;
            PG8_LDB(B0, 0, 0); PG8_LDB(B1, 0, 1); PG8_SCHED; PG8_LDA(At, 0, 0); PG8_STAGE(PG8_SA(1, 1), a1 + hstepA, voffA);
            PG8_WAIT_V(8); PG8_WAIT_L(0); PG8_BAR; PG8_MMA(0, 0, At, B0); PG8_MMA(0, 1, At, B1); PG8_BAR; PG8_SCHED;
            PG8_LDA(At, 0, 1); PG8_STAGE(PG8_SB(0, 0), b2, voffB); PG8_STAGE(PG8_SB(0, 1), b2 + hstepB, voffB); PG8_STAGE(PG8_SA(0, 0), a2, voffA);
            PG8_WAIT_V(8); PG8_WAIT_L(0); PG8_BAR; PG8_MMA(1, 0, At, B0); PG8_MMA(1, 1, At, B1); PG8_BAR; PG8_SCHED;
            PG8_LDB(B0, 1, 0); PG8_LDB(B1, 1, 1); PG8_SCHED; PG8_LDA(At, 1, 0); PG8_STAGE(PG8_SA(0, 1), a2 + hstepA, voffA);
            PG8_WAIT_V(8); PG8_WAIT_L(0); PG8_BAR; PG8_MMA(0, 0, At, B0); PG8_MMA(0, 1, At, B1); PG8_BAR; PG8_SCHED;
            PG8_LDA(At, 1, 1); PG8_STAGE(PG8_SB(1, 0), b3, voffB); PG8_STAGE(PG8_SB(1, 1), b3 + hstepB, voffB); PG8_STAGE(PG8_SA(1, 0), a3, voffA);
            PG8_WAIT_V(8); PG8_WAIT_L(0); PG8_BAR; PG8_MMA(1, 0, At, B0); PG8_MMA(1, 1, At, B1); PG8_BAR; PG8_SCHED;
        }
        if constexpr (ALIGN_EPI) { if (wr == 0) PG8_BAR; }
        E(acc, cur, wr, wc, fr, fq);
        if (!has_next) break;
#pragma unroll
        for (int a = 0; a < 2; ++a)
#pragma unroll
            for (int b = 0; b < 2; ++b)
#pragma unroll
                for (int m = 0; m < 4; ++m)
#pragma unroll
                    for (int n = 0; n < 2; ++n) acc[a][b][m][n] = (f32x4){0.f, 0.f, 0.f, 0.f};
        cur = nxt; cA = nA; cB = nB; ++ui;
        if constexpr (ALIGN_EPI) { if (wr == 1) PG8_BAR; }
    }
    PG8_WAIT_V(0);
    if constexpr (!ALIGN_EPI) { if (wr == 0) PG8_BAR; }
    PG8_BAR;
#undef PG8_SA
#undef PG8_SB
#undef PG8_STAGE
#undef PG8_LDA
#undef PG8_LDB
#undef PG8_MMA
#undef PG8_WAIT_V
#undef PG8_WAIT_L
#undef PG8_BAR
#undef PG8_SCHED
}

struct SchedIn {
    int G, c, nextra, pn0;
    __device__ __forceinline__ bool next(int i, Unit& u) const {
        const int L = i * G + c; int pm, pn;
        if (L < 384) { constexpr int nwg = 384, nN = 12, nM = 32;
            int wgid = L; { const int q = nwg / NXCD, r = nwg % NXCD, xcd = wgid % NXCD, off = wgid / NXCD; wgid = (xcd < r ? xcd * (q + 1) : r * (q + 1) + (xcd - r) * q) + off; }
            const int nig = WGM * nN, gid = wgid / nig, fm = gid * WGM, gsz = (nM - fm) < WGM ? (nM - fm) : WGM;
            pm = fm + ((wgid % nig) % gsz); pn = (wgid % nig) / gsz;
        } else { const int j = L - 384; if (j >= nextra) return false; pm = 32; pn = pn0 + j; }
        u.aoff = (long)pm * BM * 2048; u.boff = (long)pn * BM * 2048; u.orow = pm * BM; u.ocol = pn * BM; u.sel = 0; return true;
    }
};
struct SchedZW {
    int G, c;
    __device__ __forceinline__ bool next(int i, Unit& u) const {
        const int L = i * G + c; if (L >= 128) return false;
        const int pm = L & 3, pn = L >> 2, n2 = pn >> 1, h = pn & 1;
        u.aoff = (long)pm * BM * 2048; u.boff = (long)(4096 * h + n2) * 2048; u.orow = (pm & 1) * BM; u.ocol = n2 * 1024 + (pm >> 1) * 512 + h * 256; u.sel = 0; return true;
    }
};
struct SchedTiles {
    int nM, nN, nwg, G, c, lda, ldb, ocw;
    __device__ __forceinline__ bool next(int i, Unit& u) const {
        const int L = i * G + c; if (L >= nwg) return false;
        int wgid = L; { const int q = nwg / NXCD, r = nwg % NXCD, xcd = wgid % NXCD, off = wgid / NXCD; wgid = (xcd < r ? xcd * (q + 1) : r * (q + 1) + (xcd - r) * q) + off; }
        const int nig = WGM * nN, gid = wgid / nig, fm = gid * WGM, gsz = (nM - fm) < WGM ? (nM - fm) : WGM;
        const int pm = fm + ((wgid % nig) % gsz), pn = (wgid % nig) / gsz;
        u.aoff = (long)pm * BM * lda; u.boff = (long)pn * BM * ldb; u.orow = pm * BM; u.ocol = pn * ocw; u.sel = 0; return true;
    }
};
struct SchedF1 {
    int G, c;
    __device__ __forceinline__ bool next(int i, Unit& u) const {
        const int L = i * G + c; if (L >= 128) return false;
        const int n2 = L >> 3, mt = (L >> 1) & 3, dt = L & 1;
        u.aoff = (long)mt * BM * 1024; u.boff = (long)dt * BM * 16384 + n2 * 1024; u.orow = n2 * 1024 + mt * BM; u.ocol = dt * BM; u.sel = 0; return true;
    }
};
__device__ __forceinline__ void moe_map(int L, int npan, int nN, int& p, int& pn) {
    const int nwg = npan * nN;
    int wgid = L; { const int q = nwg / NXCD, r = nwg % NXCD, xcd = wgid % NXCD, off = wgid / NXCD; wgid = (xcd < r ? xcd * (q + 1) : r * (q + 1) + (xcd - r) * q) + off; }
    const int nig = WGM * nN, gid = wgid / nig, fm = gid * WGM, gsz = (npan - fm) < WGM ? (npan - fm) : WGM;
    p = fm + ((wgid % nig) % gsz); pn = (wgid % nig) / gsz;
}
struct SchedMoe {
    int npan, nN, G, c, lda, ldb, ocw; long estride; const PG8_LAS int* pe; int lim;
    __device__ __forceinline__ bool next(int i, Unit& u) const {
        const int L = i * G + c; const int nwg = npan * nN; if (L >= nwg || L >= lim) return false;
        int p, pn; moe_map(L, npan, nN, p, pn); const int e = pe[p];
        u.aoff = (long)p * BM * lda; u.boff = (long)e * estride + (long)pn * BM * ldb; u.orow = p * BM; u.ocol = pn * ocw; u.sel = 0; return true;
    }
};
struct SchedMoeTail {
    int npan, nN, G, c, lda, ldb; long estride; const PG8_LAS int* pe; int first, ksl, nsl;
    __device__ __forceinline__ bool next(int i, Unit& u) const {
        const int Lt = i * G + c; const int R = npan * nN - first; if (Lt >= nsl * R) return false;
        const int un = Lt / nsl, ks = Lt - un * nsl;
        int p, pn; moe_map(first + un, npan, nN, p, pn); const int e = pe[p];
        u.aoff = (long)p * BM * lda + ks * ksl; u.boff = (long)e * estride + (long)pn * BM * ldb + ks * ksl; u.orow = Lt * BM; u.ocol = 0; u.sel = 0; return true;
    }
};

template <int EPI, bool KBLK = false>
__device__ __forceinline__ void ctx_gemm(const bf16_t* __restrict__ A, int lda, const bf16_t* __restrict__ Bt, int ldb, int K, int ntn, int brow0,
                                         bf16_t* __restrict__ O, int ldo, int ocol0, PG8_LAS unsigned char* lds, int tid, int vcu, int G) {
    typedef unsigned u32x2_ __attribute__((ext_vector_type(2)));
    constexpr int LROW = 144;
    const int lane = tid & 63, w = __builtin_amdgcn_readfirstlane(tid >> 6), fr = lane & 15, fq = lane >> 4, mb = w >> 1, h = w & 1;
    const int srow = tid >> 3, skc = (tid & 7) * 8;
    const int nb0 = (EPI == 1) ? h : 2 * h, nb1 = (EPI == 1) ? 2 + h : 2 * h + 1;
    for (int tile = vcu; tile < 4 * ntn; tile += G) {
        const int tm = tile & 3, tn = tile >> 2;
        int brow;
        if (EPI == 1) brow = (tn >> 2) * 256 + (tn & 3) * 32 + (srow < 32 ? srow : 128 + srow - 32); else brow = brow0 + tn * 64 + srow;
        const bf16_t* ga = A + (size_t)(tm * 64 + srow) * lda + skc;
        const bf16_t* gb = KBLK ? Bt + ((size_t)(skc >> 3) * ldb + brow) * 8 : Bt + (size_t)brow * ldb + skc;
        const size_t bch = KBLK ? (size_t)64 * ldb : 64;
        f32x4 acc0 = {0.f, 0.f, 0.f, 0.f}, acc1 = {0.f, 0.f, 0.f, 0.f};
        constexpr int PD = 8;
        u32x4 ra[PD], rb[PD];
#pragma unroll
        for (int j = 0; j < PD; ++j) { ra[j] = *(const u32x4*)(ga + (size_t)j * 64); rb[j] = *(const u32x4*)(gb + (size_t)j * bch); }
        const int nch = K / 64;
        __syncthreads();
        for (int c = 0; c < nch; c += PD) {
#pragma unroll
            for (int j = 0; j < PD; ++j) {
                PG8_LAS unsigned char* sa = lds + (j & 1) * (2 * 64 * LROW); PG8_LAS unsigned char* sb = sa + 64 * LROW;
                *(PG8_LAS u32x4*)(sa + srow * LROW + skc * 2) = ra[j]; *(PG8_LAS u32x4*)(sb + srow * LROW + skc * 2) = rb[j];
                __syncthreads();
                if (c + j + PD < nch) { ra[j] = *(const u32x4*)(ga + (size_t)(c + j + PD) * 64); rb[j] = *(const u32x4*)(gb + (size_t)(c + j + PD) * bch); }
#pragma unroll
                for (int ks = 0; ks < 2; ++ks) {
                    const bf16x8 af = *(const PG8_LAS bf16x8*)(sa + (mb * 16 + fr) * LROW + (ks * 32 + fq * 8) * 2);
                    const bf16x8 b0 = *(const PG8_LAS bf16x8*)(sb + (nb0 * 16 + fr) * LROW + (ks * 32 + fq * 8) * 2);
                    const bf16x8 b1 = *(const PG8_LAS bf16x8*)(sb + (nb1 * 16 + fr) * LROW + (ks * 32 + fq * 8) * 2);
                    acc0 = __builtin_amdgcn_mfma_f32_16x16x32_bf16(b0, af, acc0, 0, 0, 0);
                    acc1 = __builtin_amdgcn_mfma_f32_16x16x32_bf16(b1, af, acc1, 0, 0, 0);
                }
            }
        }
        const int row = tm * 64 + mb * 16 + fr;
        if (EPI == 0) {
            u32x2_ w0, w1; w0.x = cvt_pk_bf16(acc0[0], acc0[1]); w0.y = cvt_pk_bf16(acc0[2], acc0[3]); w1.x = cvt_pk_bf16(acc1[0], acc1[1]); w1.y = cvt_pk_bf16(acc1[2], acc1[3]);
            bf16_t* op = O + (size_t)row * ldo + ocol0 + tn * 64 + 4 * fq;
            *(u32x2_*)(op + nb0 * 16) = w0; *(u32x2_*)(op + nb1 * 16) = w1;
        } else if (EPI == 1) {
            u32x2_ wv; wv.x = cvt_pk_bf16(silu_mul(acc0[0], acc1[0]), silu_mul(acc0[1], acc1[1])); wv.y = cvt_pk_bf16(silu_mul(acc0[2], acc1[2]), silu_mul(acc0[3], acc1[3]));
            *(u32x2_*)(O + (size_t)row * ldo + tn * 32 + h * 16 + 4 * fq) = wv;
        } else {
#pragma unroll
            for (int i = 0; i < 4; ++i) { const int d0 = tn * 64 + nb0 * 16 + 4 * fq + i, d1 = tn * 64 + nb1 * 16 + 4 * fq + i;
                O[(size_t)(d0 & 511) * 512 + (d0 >> 9) * 256 + row] = (bf16_t)(cvt_pk_bf16(acc0[i], 0.f) & 0xffffu);
                O[(size_t)(d1 & 511) * 512 + (d1 >> 9) * 256 + row] = (bf16_t)(cvt_pk_bf16(acc1[i], 0.f) & 0xffffu); }
        }
    }
    __syncthreads();
}

template <int EPI>
__device__ __forceinline__ void ctx_gemm_wide(const bf16_t* __restrict__ A, int lda, const bf16_t* __restrict__ Bt, int ldb, int Ks, int ntn, int nks,
                                              void* __restrict__ Ov, int ldo, PG8_LAS unsigned char* lds, int tid, int vcu, int G,
                                              const PG8_LAS int* pe = nullptr, int npan = 0, int first = 0, long estride = 0, int nleft = 0) {
    typedef unsigned u32x2_ __attribute__((ext_vector_type(2)));
    constexpr int LROW = 144;
    const int lane = tid & 63, w = __builtin_amdgcn_readfirstlane(tid >> 6), fr = lane & 15, fq = lane >> 4;
    const int srow = tid >> 3, skc = (tid & 7) * 8;
    const int nitems = pe ? 4 * nleft : ntn * nks;
    for (int item = vcu; item < nitems; item += G) {
        int tn, ks; const bf16_t* Ai = A; const bf16_t* Bi = Bt; void* Oi = Ov;
        if (pe) { int p_, pn_; moe_map(first + (item >> 2), npan, 56, p_, pn_); tn = pn_ * 4 + (item & 3); ks = 0;
                  Ai = A + (size_t)p_ * 256 * lda; Bi = Bt + (size_t)pe[p_] * estride; Oi = (bf16_t*)Ov + (size_t)p_ * 256 * ldo; }
        else { tn = item % ntn; ks = item / ntn; }
        const int brow = (EPI == 1) ? (tn >> 2) * 256 + (tn & 3) * 32 + (srow < 32 ? srow : 128 + srow - 32) : tn * 64 + srow;
        const bf16_t* ga = Ai + (size_t)srow * lda + (size_t)ks * Ks + skc;
        const bf16_t* gb = Bi + (size_t)brow * ldb + (size_t)ks * Ks + skc;
        f32x4 acc[2][4];
#pragma unroll
        for (int mi = 0; mi < 2; ++mi)
#pragma unroll
            for (int nb = 0; nb < 4; ++nb) acc[mi][nb] = (f32x4){0.f, 0.f, 0.f, 0.f};
        constexpr int PD = 4;
        u32x4 ra[PD][4], rb[PD];
#pragma unroll
        for (int j = 0; j < PD; ++j) {
#pragma unroll
            for (int q = 0; q < 4; ++q) ra[j][q] = *(const u32x4*)(ga + (size_t)(64 * q) * lda + (size_t)j * 64);
            rb[j] = *(const u32x4*)(gb + (size_t)j * 64); }
        const int nch = Ks / 64;
        __syncthreads();
        for (int c = 0; c < nch; c += PD) {
#pragma unroll
            for (int j = 0; j < PD; ++j) {
                PG8_LAS unsigned char* sa = lds + (j & 1) * (320 * LROW); PG8_LAS unsigned char* sb = sa + 256 * LROW;
#pragma unroll
                for (int q = 0; q < 4; ++q) *(PG8_LAS u32x4*)(sa + (srow + 64 * q) * LROW + skc * 2) = ra[j][q];
                *(PG8_LAS u32x4*)(sb + srow * LROW + skc * 2) = rb[j];
                __syncthreads();
                if (c + j + PD < nch) {
#pragma unroll
                    for (int q = 0; q < 4; ++q) ra[j][q] = *(const u32x4*)(ga + (size_t)(64 * q) * lda + (size_t)(c + j + PD) * 64);
                    rb[j] = *(const u32x4*)(gb + (size_t)(c + j + PD) * 64); }
#pragma unroll
                for (int kst = 0; kst < 2; ++kst) {
                    bf16x8 af[2], bfr[4];
#pragma unroll
                    for (int mi = 0; mi < 2; ++mi) af[mi] = *(const PG8_LAS bf16x8*)(sa + ((2 * w + mi) * 16 + fr) * LROW + (kst * 32 + fq * 8) * 2);
#pragma unroll
                    for (int nb = 0; nb < 4; ++nb) bfr[nb] = *(const PG8_LAS bf16x8*)(sb + (nb * 16 + fr) * LROW + (kst * 32 + fq * 8) * 2);
#pragma unroll
                    for (int mi = 0; mi < 2; ++mi)
#pragma unroll
                        for (int nb = 0; nb < 4; ++nb) acc[mi][nb] = __builtin_amdgcn_mfma_f32_16x16x32_bf16(bfr[nb], af[mi], acc[mi][nb], 0, 0, 0);
                }
            }
        }
#pragma unroll
        for (int mi = 0; mi < 2; ++mi) { const int row = (2 * w + mi) * 16 + fr;
            if (EPI == 1) {
#pragma unroll
                for (int hh = 0; hh < 2; ++hh) { u32x2_ wv; wv.x = cvt_pk_bf16(silu_mul(acc[mi][hh][0], acc[mi][2 + hh][0]), silu_mul(acc[mi][hh][1], acc[mi][2 + hh][1]));
                    wv.y = cvt_pk_bf16(silu_mul(acc[mi][hh][2], acc[mi][2 + hh][2]), silu_mul(acc[mi][hh][3], acc[mi][2 + hh][3]));
                    *(u32x2_*)((bf16_t*)Oi + (size_t)row * ldo + tn * 32 + hh * 16 + 4 * fq) = wv; }
            } else {
#pragma unroll
                for (int nb = 0; nb < 4; ++nb) *(f32x4*)((float*)Oi + ((size_t)ks * 256 + row) * ldo + tn * 64 + nb * 16 + 4 * fq) = acc[mi][nb];
            }
        }
    }
    __syncthreads();
}

}
namespace att {
using bf16 = __hip_bfloat16;
constexpr int D = 128, NW = 8, QBLK = 32, KVBLK = 64;
constexpr float THR = 8.f;
constexpr size_t SHM_V = KVBLK * D * 2, SHM_K = KVBLK * D * 2, SHM_ATTN = 2 * SHM_V + 2 * SHM_K + NW * 64 * 4;
using bf16x8 = __attribute__((ext_vector_type(8))) short;
using s16x4  = __attribute__((ext_vector_type(4))) short;
using f32x16 = __attribute__((ext_vector_type(16))) float;
using u32x4  = __attribute__((ext_vector_type(4))) unsigned;
#define KSWZ(row, colB) ((row) * 256 + ((colB) ^ (((row) & 7) << 4)))
#define SBAR() __builtin_amdgcn_sched_barrier(0)
__device__ __forceinline__ int crow(int r, int hi) { return (r & 3) + 8 * (r >> 2) + 4 * hi; }
__device__ __forceinline__ unsigned cvtpk(float lo, float hi) { unsigned r; asm volatile("v_cvt_pk_bf16_f32 %0, %1, %2" : "=v"(r) : "v"(lo), "v"(hi)); return r; }

__device__ __forceinline__ void expHalf(f32x16& p) { for (int r = 0; r < 16; ++r) p[r] = __builtin_amdgcn_exp2f(p[r]); }
__device__ __forceinline__ void finishSM(f32x16& p0, f32x16& p1, float& l_reg, bf16x8& pa0, bf16x8& pa1, bf16x8& pa2, bf16x8& pa3) {
  for (int r = 0; r < 16; ++r) p1[r] = __builtin_amdgcn_exp2f(p1[r]);
  float ps = 0; for (int r = 0; r < 16; ++r) ps += p0[r]; for (int r = 0; r < 16; ++r) ps += p1[r];
  l_reg += ps;
#define PK4(P, BASE, OUT) do { unsigned a0 = cvtpk(P[BASE + 0], P[BASE + 1]), a1 = cvtpk(P[BASE + 2], P[BASE + 3]);   \
    unsigned b0 = cvtpk(P[BASE + 4], P[BASE + 5]), b1 = cvtpk(P[BASE + 6], P[BASE + 7]);                              \
    auto r0 = __builtin_amdgcn_permlane32_swap(a0, b0, false, false); auto r1 = __builtin_amdgcn_permlane32_swap(a1, b1, false, false); \
    u32x4 w = {r0[0], r1[0], r0[1], r1[1]}; OUT = *reinterpret_cast<bf16x8*>(&w); } while (0)
  PK4(p0, 0, pa0); PK4(p0, 8, pa1); PK4(p1, 0, pa2); PK4(p1, 8, pa3);
#undef PK4
}
template <int DQK>
__device__ __forceinline__ void qkt(f32x16& p0, f32x16& p1, const bf16* Ks, const bf16x8* qr, int r32, int hi, int kcol) {
  p0 = f32x16{}; p1 = f32x16{};
#pragma unroll
  for (int d0 = 0; d0 < DQK / 16; ++d0) { int cb = (kcol + d0 * 16 + hi * 8) * 2;
    bf16x8 b0 = *reinterpret_cast<const bf16x8*>((const char*)Ks + KSWZ(r32, cb));
    bf16x8 b1 = *reinterpret_cast<const bf16x8*>((const char*)Ks + KSWZ(32 + r32, cb));
    p0 = __builtin_amdgcn_mfma_f32_32x32x16_bf16(b0, qr[d0], p0, 0, 0, 0);
    p1 = __builtin_amdgcn_mfma_f32_32x32x16_bf16(b1, qr[d0], p1, 0, 0, 0); }
}
__device__ __forceinline__ int v_st(int k, int c) { const int kk = (k & ~0xC) | ((k & 4) << 1) | ((k & 8) >> 1); return ((kk >> 3) * 4 + (c >> 5)) * 512 + ((kk & 7) * 32 + (c & 31)) * 2; }
__device__ __forceinline__ int v_rd_base(int lane) { return ((lane & 3) << 3) | (((lane >> 2) & 3) << 6) | (((lane >> 4) & 1) << 5) | (((lane >> 5) & 1) << 8); }
constexpr int v_rd_off(int d0, int ks, int half) { return d0 * 512 + ks * 4096 + half * 2048; }
template <int OFF> __device__ __forceinline__ s16x4 tr_read(int vb) {
  s16x4 r; asm volatile("ds_read_b64_tr_b16 %0, %1 offset:%2" : "=&v"(r) : "v"(vb), "i"(OFF) : "memory"); return r;
}
template <int D0> __device__ __forceinline__ void pv_one(f32x16& od, int vb, bf16x8 pa0, bf16x8 pa1, bf16x8 pa2, bf16x8 pa3) {
  const s16x4 l0 = tr_read<v_rd_off(D0, 0, 0)>(vb), h0 = tr_read<v_rd_off(D0, 0, 1)>(vb), l1 = tr_read<v_rd_off(D0, 1, 0)>(vb), h1 = tr_read<v_rd_off(D0, 1, 1)>(vb);
  const s16x4 l2 = tr_read<v_rd_off(D0, 2, 0)>(vb), h2 = tr_read<v_rd_off(D0, 2, 1)>(vb), l3 = tr_read<v_rd_off(D0, 3, 0)>(vb), h3 = tr_read<v_rd_off(D0, 3, 1)>(vb);
  asm volatile("s_waitcnt lgkmcnt(0)" ::: "memory"); SBAR();
#define PK(L, H) (bf16x8){L[0], L[1], L[2], L[3], H[0], H[1], H[2], H[3]}
  od = __builtin_amdgcn_mfma_f32_32x32x16_bf16(pa0, PK(l0, h0), od, 0, 0, 0);
  od = __builtin_amdgcn_mfma_f32_32x32x16_bf16(pa1, PK(l1, h1), od, 0, 0, 0);
  od = __builtin_amdgcn_mfma_f32_32x32x16_bf16(pa2, PK(l2, h2), od, 0, 0, 0);
  od = __builtin_amdgcn_mfma_f32_32x32x16_bf16(pa3, PK(l3, h3), od, 0, 0, 0);
#undef PK
}
__device__ __forceinline__ void pv_d0_exp(f32x16* o, int vb, bf16x8 pa0, bf16x8 pa1, bf16x8 pa2, bf16x8 pa3, f32x16& pe) {
  { const s16x4 l0 = tr_read<v_rd_off(0, 0, 0)>(vb), h0 = tr_read<v_rd_off(0, 0, 1)>(vb), l1 = tr_read<v_rd_off(0, 1, 0)>(vb), h1 = tr_read<v_rd_off(0, 1, 1)>(vb);
    const s16x4 l2 = tr_read<v_rd_off(0, 2, 0)>(vb), h2 = tr_read<v_rd_off(0, 2, 1)>(vb), l3 = tr_read<v_rd_off(0, 3, 0)>(vb), h3 = tr_read<v_rd_off(0, 3, 1)>(vb);
    SBAR(); expHalf(pe); SBAR();
    asm volatile("s_waitcnt lgkmcnt(0)" ::: "memory"); SBAR();
#define PK(L, H) (bf16x8){L[0], L[1], L[2], L[3], H[0], H[1], H[2], H[3]}
    o[0] = __builtin_amdgcn_mfma_f32_32x32x16_bf16(pa0, PK(l0, h0), o[0], 0, 0, 0);
    o[0] = __builtin_amdgcn_mfma_f32_32x32x16_bf16(pa1, PK(l1, h1), o[0], 0, 0, 0);
    o[0] = __builtin_amdgcn_mfma_f32_32x32x16_bf16(pa2, PK(l2, h2), o[0], 0, 0, 0);
    o[0] = __builtin_amdgcn_mfma_f32_32x32x16_bf16(pa3, PK(l3, h3), o[0], 0, 0, 0);
#undef PK
  }
  pv_one<1>(o[1], vb, pa0, pa1, pa2, pa3); pv_one<2>(o[2], vb, pa0, pa1, pa2, pa3); pv_one<3>(o[3], vb, pa0, pa1, pa2, pa3);
}
__device__ __forceinline__ void pv_d0(f32x16* o, int vb, bf16x8 pa0, bf16x8 pa1, bf16x8 pa2, bf16x8 pa3) {
  pv_one<0>(o[0], vb, pa0, pa1, pa2, pa3); pv_one<1>(o[1], vb, pa0, pa1, pa2, pa3); pv_one<2>(o[2], vb, pa0, pa1, pa2, pa3); pv_one<3>(o[3], vb, pa0, pa1, pa2, pa3);
}

template <int DQK, bool OF32, int LDP>
__device__ __forceinline__ void attn_unit(const bf16* __restrict__ Qb, const bf16* __restrict__ Kh, const bf16* __restrict__ Vh, void* __restrict__ Ob, int ldo, int seq, int kcol, char* lds) {
  int tid_ = threadIdx.x; asm volatile("" : "+v"(tid_));
  const int tid = tid_, wid = tid >> 6, lane = tid & 63, r32 = lane & 31, hi = lane >> 5;
  bf16* V_lds = (bf16*)lds; bf16* K_lds = (bf16*)(lds + 2 * SHM_V);
  float* ws = (float*)(lds + 2 * SHM_V + 2 * SHM_K) + wid * 64; float* li_l = ws;
  float l_reg = 0; f32x16 o[4] = {}; bf16x8 qr[DQK / 16];
  const bf16* Qw = Qb + (long)(wid * QBLK + r32) * LDP + hi * 8;
#pragma unroll
  for (int d0 = 0; d0 < DQK / 16; ++d0) qr[d0] = *reinterpret_cast<const bf16x8*>(Qw + d0 * 16);
  const int sr = tid >> 4, sc = (tid & 15) * 8, vst0 = v_st(sr, sc), vst1 = v_st(32 + sr, sc);
  const int vb0 = (int)(uintptr_t)V_lds + v_rd_base(lane);
  struct { bf16x8 vs0, vs1, ks0, ks1; } sr_[1];
#define SLOAD(i, k0) do { sr_[i].vs0 = *reinterpret_cast<const bf16x8*>(&Vh[(long)((k0) + sr) * LDP + sc]); sr_[i].vs1 = *reinterpret_cast<const bf16x8*>(&Vh[(long)((k0) + 32 + sr) * LDP + sc]); \
    sr_[i].ks0 = *reinterpret_cast<const bf16x8*>(&Kh[(long)((k0) + sr) * LDP + sc]); sr_[i].ks1 = *reinterpret_cast<const bf16x8*>(&Kh[(long)((k0) + 32 + sr) * LDP + sc]); } while (0)
#define SWRITE(b, i) do { *(bf16x8*)((char*)V_lds + (b) * SHM_V + vst0) = sr_[i].vs0;          \
    *(bf16x8*)((char*)V_lds + (b) * SHM_V + vst1) = sr_[i].vs1; int kc = sc * 2;               \
    *(bf16x8*)((char*)K_lds + (b) * SHM_K + KSWZ(sr, kc)) = sr_[i].ks0;                       \
    *(bf16x8*)((char*)K_lds + (b) * SHM_K + KSWZ(32 + sr, kc)) = sr_[i].ks1; } while (0)
#define SWAIT() asm volatile("s_waitcnt vmcnt(0)" ::: "memory")
  f32x16 pA0, pA1, pB0, pB1; bf16x8 pa0, pa1, pa2, pa3; const int NT = seq / KVBLK;
  constexpr int SE = 0, SO = 0;
  if (__builtin_amdgcn_readfirstlane(tid) >= 256) __builtin_amdgcn_s_setprio(1);
  SLOAD(SE, 0); asm volatile("s_waitcnt vmcnt(0)" ::: "memory"); SWRITE(0, SE); __syncthreads();
  qkt<DQK>(pA0, pA1, K_lds, qr, r32, hi, kcol); SBAR(); expHalf(pA0); SBAR();
  SLOAD(SO, KVBLK);
  SWAIT(); SWRITE(1, SO); __syncthreads();
  for (int j = 1; j + 1 < NT; j += 2) {
    SLOAD(SO, (j + 1) * KVBLK);
    SBAR(); qkt<DQK>(pB0, pB1, (bf16*)((char*)K_lds + SHM_K), qr, r32, hi, kcol);
    finishSM(pA0, pA1, l_reg, pa0, pa1, pa2, pa3); SBAR();
    pv_d0_exp(o, vb0, pa0, pa1, pa2, pa3, pB0); SBAR();
    __syncthreads(); SWAIT(); SWRITE(0, SE);
    __syncthreads();
    SLOAD(SE, (j + 2) * KVBLK);
    SBAR(); qkt<DQK>(pA0, pA1, K_lds, qr, r32, hi, kcol);
    finishSM(pB0, pB1, l_reg, pa0, pa1, pa2, pa3); SBAR();
    pv_d0_exp(o, vb0 + (int)SHM_V, pa0, pa1, pa2, pa3, pA0); SBAR();
    __syncthreads(); SWAIT(); SWRITE(1, SO);
    __syncthreads();
  }
  SBAR(); qkt<DQK>(pB0, pB1, (bf16*)((char*)K_lds + SHM_K), qr, r32, hi, kcol);
  finishSM(pA0, pA1, l_reg, pa0, pa1, pa2, pa3); SBAR();
  pv_d0_exp(o, vb0, pa0, pa1, pa2, pa3, pB0); SBAR();
  __syncthreads();
  finishSM(pB0, pB1, l_reg, pa0, pa1, pa2, pa3); SBAR();
  pv_d0(o, vb0 + (int)SHM_V, pa0, pa1, pa2, pa3);
  __builtin_amdgcn_s_setprio(0);
  { auto rr = __builtin_amdgcn_permlane32_swap(__float_as_uint(l_reg), __float_as_uint(l_reg), false, false); l_reg = __uint_as_float(rr[0]) + __uint_as_float(rr[1]); }
  if (hi == 0) li_l[r32] = l_reg; asm volatile("s_waitcnt lgkmcnt(0)" ::: "memory");
  float rli[16];
#pragma unroll
  for (int r = 0; r < 16; ++r) rli[r] = __builtin_amdgcn_rcpf(li_l[crow(r, hi)]);
  if constexpr (OF32) {
    float* Ow = (float*)Ob + (long)(wid * QBLK) * ldo;
#pragma unroll
    for (int r = 0; r < 16; ++r) { int orow = crow(r, hi);
      for (int d0 = 0; d0 < 4; ++d0) Ow[(long)orow * ldo + d0 * 32 + r32] = o[d0][r] * rli[r]; }
  } else {
    bf16* Ow = (bf16*)Ob + (long)(wid * QBLK) * ldo;
#pragma unroll
    for (int r = 0; r < 16; ++r) { int orow = crow(r, hi);
      for (int d0 = 0; d0 < 4; ++d0) Ow[(long)orow * ldo + d0 * 32 + r32] = __float2bfloat16(o[d0][r] * rli[r]); }
  }
  __syncthreads();
#undef SLOAD
#undef SWRITE
#undef SWAIT
}
#undef KSWZ
#undef SBAR
}
#ifndef REP_P0
#define REP_P0 1
#endif
#ifndef REP_K0
#define REP_K0 1
#endif
#ifndef REP_K2
#define REP_K2 1
#endif
#ifndef REP_K4
#define REP_K4 1
#endif
#ifndef REP_K5
#define REP_K5 1
#endif
#ifndef WIDE_MAX
#define WIDE_MAX 128
#endif
#ifndef REP_K7
#define REP_K7 1
#endif
#ifndef REP_K8
#define REP_K8 1
#endif
constexpr int NWAVES = 8, NTHREADS = 512;
constexpr int DM = 2048, NLAT = 8192, NCTX = 256, MR = NLAT + NCTX, DFF = 7168, NEXP = 8;
constexpr int PC = 3072;
constexpr int PC_QA = 0, PC_QB = 1024, PC_KA = 1536, PC_VA = 1792, PC_KB = 2048, PC_VB = 2560;
constexpr int WIN_ROWS = 4096;
constexpr int MOE_ROWS = 2 * NLAT + NEXP * 256;
constexpr float EPS = 1e-6f;
constexpr size_t MiB = 1u << 20;
constexpr size_t WS_CTL = 0, CTL_ZERO_BYTES = 1 * MiB;
constexpr size_t WS_MOD = 1 * MiB;
constexpr size_t WS_BF = WS_MOD + 256 * 1024;
constexpr size_t WS_TOK = 3 * MiB;
constexpr size_t WS_WGCNT = WS_TOK + 512 * 1024;
constexpr size_t WS_DFTC = 4 * MiB;
constexpr size_t WS_ZWTC = WS_DFTC + 512 * 1024;
constexpr size_t WS_WIN = 8 * MiB;
constexpr size_t WS_WOUT = 40 * MiB;
constexpr size_t WS_WGU = 56 * MiB;
constexpr size_t WS_WDN = 112 * MiB;
constexpr size_t WS_MGU = 140 * MiB;
constexpr size_t WS_MDN = 588 * MiB;
constexpr size_t WS_DFT = 812 * MiB;
constexpr size_t WS_X = 1068 * MiB;
constexpr size_t WS_H = 1134 * MiB;
constexpr size_t WS_O = 1167 * MiB;
constexpr size_t WS_P = 1200 * MiB;
constexpr size_t WS_ZWT = 1250 * MiB;
constexpr size_t WS_DIFFO = 1266 * MiB;
constexpr size_t WS_FP = 1299 * MiB;
constexpr size_t WS_Y = 1363 * MiB;
constexpr size_t WS_ACT = 1200 * MiB;
constexpr size_t WS_HS = 1200 * MiB;
constexpr size_t WS_DOUT = 1272 * MiB;
constexpr size_t WS_MACT = WS_DFT;
constexpr size_t WS_PART = 1344 * MiB;
constexpr size_t WS_END = 1412 * MiB;
constexpr int CW_TMO = 0, CW_BAR = 4096, CW_KMX = 8192, CW_TAIL = 9216;

constexpr int RING_BYTES = 131072, LDSCTL_OFF = RING_BYTES, MISC_OFF = LDSCTL_OFF + 12288, LDS_BYTES = 147456;

#define GAS __attribute__((address_space(1)))
#define LAS __attribute__((address_space(3)))
typedef unsigned short bf16_t;
typedef float f32x4 __attribute__((ext_vector_type(4)));
typedef unsigned u32x2 __attribute__((ext_vector_type(2)));
typedef unsigned u32x4 __attribute__((ext_vector_type(4)));

#define XB_TMO      128
#define XB_XCNT(j)  (256  + 64 * (j))
#define XB_XSUB(j)  (1280 + 64 * (j))
#define XB_XGEN(j)  (2304 + 64 * (j))
#define XB_TOP      3328
#define XB_TOPGEN   3392
#define XCD_BAR_WORDS 3456
#define XB_SPIN_CAP (1u << 18)
__device__ __forceinline__ unsigned xb_ld(unsigned* p)              { return __hip_atomic_load(p, __ATOMIC_RELAXED, __HIP_MEMORY_SCOPE_AGENT); }
__device__ __forceinline__ unsigned xb_add(unsigned* p, unsigned v) { return __hip_atomic_fetch_add(p, v, __ATOMIC_RELAXED, __HIP_MEMORY_SCOPE_AGENT); }
__device__ __forceinline__ unsigned xb_xcc_id() { return (unsigned)__builtin_amdgcn_s_getreg((3 << 11) | 20) & 0xFu; }
#define XB_SPIN(cond, bar) do { unsigned _sp = 0; while (cond) { __builtin_amdgcn_s_sleep(1); \
    if ((++_sp & 255u) == 0u) { if (xb_ld(&(bar)[XB_TMO])) break; if (_sp > XB_SPIN_CAP) { atomicAdd(&(bar)[XB_TMO], 1u); break; } } } } while (0)
struct XcdBarrier { unsigned* bar; unsigned x; volatile LAS unsigned* st; };
__device__ __forceinline__ XcdBarrier xcd_barrier_post(unsigned* bar, volatile LAS unsigned* st) {
    XcdBarrier b; b.bar = bar; b.x = xb_xcc_id(); b.st = st;
    if (threadIdx.x == 0) (void)xb_add(&bar[XB_XCNT(b.x)], 1u);
    return b;
}
__device__ __forceinline__ void xcd_barrier_complete(unsigned* bar, unsigned x, unsigned& nloc, unsigned& nx) {
    const unsigned G = gridDim.x * gridDim.y * gridDim.z;
    unsigned sum, cnt, mine, sp = 0u;
    for (;;) {
        sum = 0u; cnt = 0u; mine = 0u;
#pragma unroll
        for (unsigned j = 0; j < 16; ++j) { const unsigned c = xb_ld(&bar[XB_XCNT(j)]); sum += c; cnt += (c > 0u) ? 1u : 0u; mine = (j == x) ? c : mine; }
        if (sum == G) break;
        __builtin_amdgcn_s_sleep(1);
        if ((++sp & 255u) == 0u) { if (xb_ld(&bar[XB_TMO])) break; if (sp > XB_SPIN_CAP) { atomicAdd(&bar[XB_TMO], 1u); break; } }
    }
    nloc = mine > 0u ? mine : 1u; nx = cnt > 0u ? cnt : 1u;
}
__device__ __forceinline__ void xcd_barrier(const XcdBarrier& b) {
    asm volatile("s_waitcnt vmcnt(0)" ::: "memory");
    __syncthreads();
    if (threadIdx.x == 0) {
        unsigned* bar = b.bar; asm volatile("" : "+s"(bar));
        __builtin_amdgcn_s_waitcnt(0);
        unsigned nloc = b.st[0], nx = b.st[1];
        if (nloc == 0u) { xcd_barrier_complete(bar, b.x, nloc, nx); b.st[0] = nloc; b.st[1] = nx; }
        const unsigned old = xb_add(&bar[XB_XSUB(b.x)], 1u);
        const unsigned gen = old / nloc;
        if (old + 1u == (gen + 1u) * nloc) {
            __builtin_amdgcn_fence(__ATOMIC_RELEASE, "agent");
            asm volatile("s_waitcnt vmcnt(0)" ::: "memory");
            const unsigned og = xb_add(&bar[XB_TOP], 1u);
            const unsigned tg = og / nx;
            if (og + 1u == (tg + 1u) * nx) xb_add(&bar[XB_TOPGEN], 1u);
            else XB_SPIN(xb_ld(&bar[XB_TOPGEN]) == tg, bar);
            __builtin_amdgcn_fence(__ATOMIC_ACQUIRE, "agent");
            xb_add(&bar[XB_XGEN(b.x)], 1u);
            asm volatile("s_waitcnt vmcnt(0)" ::: "memory");
        } else {
            XB_SPIN(xb_ld(&bar[XB_XGEN(b.x)]) == gen, bar);
            __builtin_amdgcn_fence(__ATOMIC_ACQUIRE, "agent");
            asm volatile("s_waitcnt vmcnt(0)" ::: "memory");
        }
    }
    __syncthreads();
}

#define LDS_WAIT() asm volatile("s_waitcnt lgkmcnt(0)" ::: "memory")
__device__ __forceinline__ float wave_sum(float v) {
#pragma unroll
    for (int o = 1; o < 64; o <<= 1) v += __shfl_xor(v, o);
    return v;
}
__device__ __forceinline__ unsigned pk2(float lo, float hi) { return pg8::cvt_pk_bf16(lo, hi); }
__device__ __forceinline__ float bf_lo(unsigned u) { return __uint_as_float(u << 16); }
__device__ __forceinline__ float bf_hi(unsigned u) { return __uint_as_float(u & 0xffff0000u); }
__device__ __forceinline__ float silu_f(float v) { return v / (1.0f + __expf(-v)); }
__device__ __forceinline__ void ld_row_f32(const float* p, int lane, f32x4 (&v)[8]) {
    const f32x4* q = (const f32x4*)p + lane;
#pragma unroll
    for (int j = 0; j < 8; ++j) v[j] = q[64 * j];
}
__device__ __forceinline__ void ld_row_bf16(const bf16_t* p, int lane, f32x4 (&v)[8]) {
    const u32x2* q = (const u32x2*)p + lane;
#pragma unroll
    for (int j = 0; j < 8; ++j) { const u32x2 w = q[64 * j]; v[j] = (f32x4){bf_lo(w.x), bf_hi(w.x), bf_lo(w.y), bf_hi(w.y)}; }
}
__device__ __forceinline__ void st_row_bf16(bf16_t* p, int lane, const f32x4 (&v)[8]) {
    u32x2* q = (u32x2*)p + lane;
#pragma unroll
    for (int j = 0; j < 8; ++j) { u32x2 w; w.x = pk2(v[j].x, v[j].y); w.y = pk2(v[j].z, v[j].w); q[64 * j] = w; }
}
__device__ __forceinline__ void st_row_f32(float* p, int lane, const f32x4 (&v)[8]) {
    f32x4* q = (f32x4*)p + lane;
#pragma unroll
    for (int j = 0; j < 8; ++j) q[64 * j] = v[j];
}
__device__ __forceinline__ void ld_row_f32_nt(const float* p, int lane, f32x4 (&v)[8]) {
    const f32x4* q = (const f32x4*)p + lane;
#pragma unroll
    for (int j = 0; j < 8; ++j) v[j] = __builtin_nontemporal_load(q + 64 * j);
}
__device__ __forceinline__ void st_row_f32_nt(float* p, int lane, const f32x4 (&v)[8]) {
    f32x4* q = (f32x4*)p + lane;
#pragma unroll
    for (int j = 0; j < 8; ++j) __builtin_nontemporal_store(v[j], q + 64 * j);
}
__device__ __forceinline__ float row_sumsq(const f32x4 (&v)[8]) {
    float s = 0.f;
#pragma unroll
    for (int j = 0; j < 8; ++j) s += (v[j].x * v[j].x + v[j].y * v[j].y) + (v[j].z * v[j].z + v[j].w * v[j].w);
    return wave_sum(s);
}

__device__ __forceinline__ void transpose_item(const float* __restrict__ src, size_t ld, int k0, int c0, bf16_t* __restrict__ dst, size_t ldd, int r0, LAS float* scr, int lane) {
    const int lr = lane >> 3, lc = (lane & 7) * 4;
    f32x4 t[8];
#pragma unroll
    for (int i = 0; i < 8; ++i) t[i] = __builtin_nontemporal_load((const f32x4*)(src + (size_t)(k0 + 8 * i + lr) * ld + c0 + lc));
#pragma unroll
    for (int i = 0; i < 8; ++i) { LAS float* s = scr + (8 * i + lr) * 33 + lc; s[0] = t[i].x; s[1] = t[i].y; s[2] = t[i].z; s[3] = t[i].w; }
    LDS_WAIT(); asm volatile("" ::: "memory");
    const int c = lane & 7;
#pragma unroll
    for (int j = 0; j < 4; ++j) { const int n = (lane >> 3) + 8 * j; const LAS float* s = scr + (8 * c) * 33 + n;
        u32x4 o; o.x = pk2(s[0 * 33], s[1 * 33]); o.y = pk2(s[2 * 33], s[3 * 33]); o.z = pk2(s[4 * 33], s[5 * 33]); o.w = pk2(s[6 * 33], s[7 * 33]);
        __builtin_nontemporal_store(o, (u32x4*)(dst + (size_t)(r0 + n) * ldd + k0 + 8 * c)); }
    LDS_WAIT(); asm volatile("" ::: "memory");
}
__device__ __forceinline__ void transpose_item64(const float* __restrict__ src, size_t ld, int k0, int c0, bf16_t* __restrict__ dst, size_t ldd, int r0, LAS float* scr, int lane) {
    const int lr = lane >> 4, lc = (lane & 15) * 4;
    f32x4 t[16];
#pragma unroll
    for (int i = 0; i < 16; ++i) t[i] = __builtin_nontemporal_load((const f32x4*)(src + (size_t)(k0 + 4 * i + lr) * ld + c0 + lc));
#pragma unroll
    for (int i = 0; i < 16; ++i) { LAS float* s = scr + (4 * i + lr) * 65 + lc; s[0] = t[i].x; s[1] = t[i].y; s[2] = t[i].z; s[3] = t[i].w; }
    LDS_WAIT(); asm volatile("" ::: "memory");
    const int c = lane & 7;
#pragma unroll
    for (int j = 0; j < 8; ++j) { const int n = (lane >> 3) + 8 * j; const LAS float* s = scr + (8 * c) * 65 + n;
        u32x4 o; o.x = pk2(s[0 * 65], s[1 * 65]); o.y = pk2(s[2 * 65], s[3 * 65]); o.z = pk2(s[4 * 65], s[5 * 65]); o.w = pk2(s[6 * 65], s[7 * 65]);
        __builtin_nontemporal_store(o, (u32x4*)(dst + (size_t)(r0 + n) * ldd + k0 + 8 * c)); }
    LDS_WAIT(); asm volatile("" ::: "memory");
}
struct Args { const float* in[27]; float* out; unsigned char* ws; int ph_lo, ph_hi; };
__device__ __forceinline__ const float* inptr(const Args& a, int k) { asm volatile("" : "+s"(k)); return a.in[k]; }
__device__ __forceinline__ unsigned char* wsptr(const Args& a, size_t off) { unsigned char* p = a.ws; asm volatile("" : "+s"(p)); return p + off; }

__device__ __forceinline__ const float* modp(const unsigned char* ws, int l, int v, int chunk) { return (const float*)(ws + WS_MOD) + ((size_t)(l * 2 + v) * 6 + chunk) * DM; }

__device__ __forceinline__ void moe_tables(const unsigned char* ws, LAS unsigned char* ldsctl, LAS unsigned char* tmp, bool want_base, int G) {
    LAS int* T = (LAS int*)ldsctl; LAS int* W = (LAS int*)tmp;
    const int* wg = (const int*)(ws + WS_WGCNT);
    int tid = threadIdx.x; asm volatile("" : "+v"(tid));
    __syncthreads();
    for (int i = tid; i < G * 8; i += NTHREADS) W[i] = wg[i];
    __syncthreads();
    if (tid < 8) { int s = 0; for (int w = 0; w < G; ++w) s += W[w * 8 + tid]; T[16 + tid] = s; }
    __syncthreads();
    if (tid == 0) { int o = 0; for (int e = 0; e < 8; ++e) { T[e] = o; o += ((T[16 + e] + 255) >> 8) << 8; } T[8] = o; T[32] = o >> 8; }
    __syncthreads();
    if (tid < 72) { const int r = tid * 256; int e = 0;
#pragma unroll
        for (int j = 1; j < 8; ++j) e += (T[j] <= r) ? 1 : 0;
        T[64 + tid] = e; }
    if (want_base && tid < 8) { int s = T[tid]; for (int w = 0; w < G; ++w) { T[256 + w * 8 + tid] = s; s += W[w * 8 + tid]; } }
    __syncthreads();
}

constexpr int J_GU = 32 * 448, J_DN = 112 * 64, J_FFN = J_GU + J_DN;
__device__ __forceinline__ void ffn_weight_item(int e, int r, const float* w_gate_d, const float* w_up_d, const float* w_down_d, const float* w_gate_m, const float* w_up_m, const float* w_down_m,
                                                bf16_t* WGU, bf16_t* WDN, bf16_t* MGU, bf16_t* MDN, LAS float* scr, int lane) {
    if (r < J_GU) { const int kb = r / 448, nb = r % 448; const int n0 = nb * 32; const int tile = n0 >> 8, half = (n0 >> 7) & 1, j0 = n0 & 127;
        const float* src = e == 0 ? (half ? w_up_d : w_gate_d) : (half ? w_up_m : w_gate_m) + (size_t)(e - 1) * DM * DFF;
        bf16_t* dst = e == 0 ? WGU : MGU + (size_t)(e - 1) * 2 * DFF * DM;
        transpose_item(src, DFF, kb * 64, tile * 128 + j0, dst, DM, n0, scr, lane); }
    else { r -= J_GU; const int kb = r / 64, nb = r % 64;
        const float* src = e == 0 ? w_down_d : w_down_m + (size_t)(e - 1) * DFF * DM;
        bf16_t* dst = e == 0 ? WDN : MDN + (size_t)(e - 1) * DM * DFF;
        transpose_item(src, DM, kb * 64, nb * 32, dst, DFF, nb * 32, scr, lane); }
}

__global__ void __launch_bounds__(NTHREADS, 2) fwd_kernel(Args args) {
    extern __shared__ __attribute__((aligned(16))) unsigned char lds[];
    LAS unsigned char* L = (LAS unsigned char*)lds;
    volatile LAS unsigned* MISC = (volatile LAS unsigned*)(L + MISC_OFF);
    const int tid0 = threadIdx.x;
    const int G = gridDim.x, bx = blockIdx.x;
    const int vcu = (G % 8 == 0) ? (bx % 8) * (G / 8) + bx / 8 : bx;
    const int NGW = G * NWAVES;
#define PHASE_LOCALS int tid = tid0; asm volatile("" : "+v"(tid)); const int lane = tid & 63, wave = __builtin_amdgcn_readfirstlane(tid >> 6), gw = vcu * NWAVES + wave; (void)lane; (void)wave; (void)gw;
    unsigned char* ws = args.ws;
    unsigned* ctl = (unsigned*)(ws + WS_CTL);
    for (int u = tid0; u < (LDS_BYTES - LDSCTL_OFF) / 4; u += NTHREADS) ((LAS unsigned*)(L + LDSCTL_OFF))[u] = 0u;
    __syncthreads();
    XcdBarrier bar = xcd_barrier_post(ctl + CW_BAR, MISC + 8);
    const int lo = args.ph_lo, hi = args.ph_hi;
#define IN(k) (lo <= (k) && (k) < hi)
#define SEAM(k) do { if (IN(k) && IN((k) + 1)) xcd_barrier(bar); } while (0)

    const float* x_in = args.in[0]; const float* c_in = args.in[1]; const float* ctx_in = args.in[2]; const float* cctx_in = args.in[3];
    const float* w_mod = args.in[4]; const float* b_mod = args.in[5];
    const float* g_pre_mix = args.in[6]; const float* g_post_mix = args.in[7]; const float* g_pre_ffn = args.in[8]; const float* g_post_ffn = args.in[9];
    const float* w_in = args.in[10]; const float* g_q_a = args.in[11]; const float* g_k_a = args.in[12];
    const float* lq1 = args.in[13]; const float* lk1 = args.in[14]; const float* lq2 = args.in[15]; const float* lk2 = args.in[16];
    const float* g_subln = args.in[17]; const float* w_fourier = args.in[18]; const float* w_out = args.in[19];
    const float* w_gate_d = args.in[20]; const float* w_up_d = args.in[21]; const float* w_down_d = args.in[22]; const float* w_router = args.in[23];
    const float* w_gate_m = args.in[24]; const float* w_up_m = args.in[25]; const float* w_down_m = args.in[26];
    bf16_t* WIN = (bf16_t*)(ws + WS_WIN); bf16_t* WOUT = (bf16_t*)(ws + WS_WOUT); bf16_t* WGU = (bf16_t*)(ws + WS_WGU); bf16_t* WDN = (bf16_t*)(ws + WS_WDN);
    bf16_t* MGU = (bf16_t*)(ws + WS_MGU); bf16_t* MDN = (bf16_t*)(ws + WS_MDN); bf16_t* DFT = (bf16_t*)(ws + WS_DFT); bf16_t* DFTC = (bf16_t*)(ws + WS_DFTC);
    float* X = (float*)(ws + WS_X); bf16_t* H = (bf16_t*)(ws + WS_H); bf16_t* O = (bf16_t*)(ws + WS_O); bf16_t* P = (bf16_t*)(ws + WS_P);
    bf16_t* ZWT = (bf16_t*)(ws + WS_ZWT); bf16_t* ZWTC = (bf16_t*)(ws + WS_ZWTC); bf16_t* DIFFO = (bf16_t*)(ws + WS_DIFFO); bf16_t* Y1 = (bf16_t*)(ws + WS_FP);
    bf16_t* Y = (bf16_t*)(ws + WS_Y); bf16_t* ACT = (bf16_t*)(ws + WS_ACT); bf16_t* HS = (bf16_t*)(ws + WS_HS); bf16_t* DOUT = (bf16_t*)(ws + WS_DOUT); bf16_t* MACT = (bf16_t*)(ws + WS_MACT);
    float* BF = (float*)(ws + WS_BF); unsigned* TOK = (unsigned*)(ws + WS_TOK); int* WGCNT = (int*)(ws + WS_WGCNT);

    if (IN(0)) for (int rep_ = 0; rep_ < REP_P0; ++rep_) {
        PHASE_LOCALS
        {
            LAS float* sl = (LAS float*)L; LAS float* scx = sl + DM; LAS float* red = scx + DM;
            __syncthreads();
            for (int k = tid; k < DM; k += NTHREADS) { sl[k] = silu_f(c_in[k]); scx[k] = silu_f(cctx_in[k]); }
            __syncthreads();
            for (int job = vcu; job < 256; job += G) {
                const int l = job >> 7, cg = job & 127;
                const float* wm = w_mod + (size_t)l * DM * 12288 + cg * 96;
                const int c4 = tid % 24, rg = tid / 24;
                f32x4 al = {0.f, 0.f, 0.f, 0.f}, ac = {0.f, 0.f, 0.f, 0.f};
                if (rg < 21) {
#pragma unroll 14
                    for (int k = rg; k < DM; k += 21) { const f32x4 w = __builtin_nontemporal_load((const f32x4*)(wm + (size_t)k * 12288 + c4 * 4));     const float a = sl[k], b = scx[k]; al += w * a; ac += w * b; }
                    LAS float* r = red + (rg * 24 + c4) * 8; r[0] = al.x; r[1] = al.y; r[2] = al.z; r[3] = al.w; r[4] = ac.x; r[5] = ac.y; r[6] = ac.z; r[7] = ac.w;
                }
                __syncthreads();
                if (tid < 192) { const int v = tid / 96, col = tid % 96; float s = 0.f; for (int r = 0; r < 21; ++r) s += red[(r * 24 + (col >> 2)) * 8 + v * 4 + (col & 3)];
                    ((float*)(ws + WS_MOD))[(size_t)(l * 2 + v) * 12288 + cg * 96 + col] = s + b_mod[(size_t)l * 12288 + cg * 96 + col]; }
                __syncthreads();
            }
        }
        for (int job = vcu; job < 16; job += G) {
            const int l = job >> 3, part = (job >> 2) & 1, g = job & 3;
            LAS float* Wl = (LAS float*)L; LAS float* tb = Wl + 128 * 128;
            const float* W = w_fourier + (size_t)(l * 4 + g) * 128 * 128;
            for (int i = tid; i < 128 * 128; i += NTHREADS) Wl[i] = W[i];
            if (tid < 128) { const float ph = (float)tid * (1.0f / 128.0f); tb[tid] = (part ? -__builtin_amdgcn_sinf(ph) : __builtin_amdgcn_cosf(ph)) * 0.08838834764831845f; }
            __syncthreads();
            const int d4 = tid & 31, cg = tid >> 5;
            f32x4 acc[8];
#pragma unroll
            for (int i = 0; i < 8; ++i) acc[i] = (f32x4){0.f, 0.f, 0.f, 0.f};
#pragma unroll 2
            for (int lp = 0; lp < 128; ++lp) { const f32x4 wv = *(const LAS f32x4*)(Wl + lp * 128 + 4 * d4);
#pragma unroll
                for (int i = 0; i < 8; ++i) acc[i] += wv * tb[(lp * (cg * 8 + i)) & 127]; }
            float* out = BF + ((size_t)((l * 2 + part) * 4 + g) * 128) * 128;
#pragma unroll
            for (int i = 0; i < 8; ++i) *(f32x4*)(out + (size_t)(cg * 8 + i) * 128 + 4 * d4) = acc[i];
            __syncthreads();
        }
        {
            const int gt = vcu * NTHREADS + tid, NT = G * NTHREADS;
            for (int i = gt; i < 1024 * 128; i += NT) { const int m = i >> 7, c8 = (i & 127) * 8; const int ro = m >> 9, k1 = m & 511, part = c8 >> 9, n1 = c8 & 511;
                float v[8];
#pragma unroll
                for (int j = 0; j < 8; ++j) { const float ph = (float)((k1 * (n1 + j)) & 511) * (1.0f / 512.0f); const float cs = __builtin_amdgcn_cosf(ph), sn = __builtin_amdgcn_sinf(ph);
                    v[j] = (ro == 0 ? (part == 0 ? cs : sn) : (part == 0 ? -sn : cs)) * 0.011048543456039806f; }
                u32x4 o; o.x = pk2(v[0], v[1]); o.y = pk2(v[2], v[3]); o.z = pk2(v[4], v[5]); o.w = pk2(v[6], v[7]);
                *(u32x4*)(DFT + (size_t)i * 8) = o; }
            for (int i = gt; i < NCTX * 64; i += NT) { const int k = i >> 6, n8 = (i & 63) * 8; const int part = n8 >= NCTX; const int n = n8 & (NCTX - 1);
                float v[8];
#pragma unroll
                for (int j = 0; j < 8; ++j) { const float ph = (float)((k * (n + j)) & (NCTX - 1)) * (1.0f / NCTX); v[j] = (part ? __builtin_amdgcn_sinf(ph) : __builtin_amdgcn_cosf(ph)) * 0.0625f; }
                u32x4 o; o.x = pk2(v[0], v[1]); o.y = pk2(v[2], v[3]); o.z = pk2(v[4], v[5]); o.w = pk2(v[6], v[7]);
                *(u32x4*)(DFTC + (size_t)i * 8) = o; }
        }
        {
            LAS float* scr = (LAS float*)(L + wave * 16640);
            constexpr int I_IN = 32 * 96, I_OUT = 32 * 64;
            constexpr int NITEMS = 2 * I_IN + 2 * I_OUT;
            for (int it = gw; it < NITEMS; it += NGW) {
                int r = it;
                if (r < 2 * I_IN) { const int l = r / I_IN; r %= I_IN; const int kb = r / 96, nb = r % 96; const int n0 = nb * 32; const int c0 = n0 < 1536 ? n0 : n0 + 512;
                    transpose_item(w_in + (size_t)l * DM * 3584, 3584, kb * 64, c0, WIN + (size_t)l * WIN_ROWS * DM, DM, n0, scr, lane); continue; }
                r -= 2 * I_IN;
                { const int l = r / I_OUT; r %= I_OUT; const int kb = r / 64, nb = r % 64;
                    transpose_item(w_out + (size_t)l * DM * DM, DM, kb * 64, nb * 32, WOUT + (size_t)l * DM * DM, DM, nb * 32, scr, lane); }
            }
            { LAS float* scr64 = (LAS float*)(L + wave * 16640); const int npro = (G % 2 == 0) ? 1 : 9;
              for (int it = gw; it < npro * J_FFN; it += NGW) ffn_weight_item(it / J_FFN, it % J_FFN, w_gate_d, w_up_d, w_down_d, w_gate_m, w_up_m, w_down_m, WGU, WDN, MGU, MDN, scr64, lane); }
        }
    }
    SEAM(0);

    if (IN(1)) {
        PHASE_LOCALS
        for (int job = vcu; job < 512; job += G) {
            const int l = job >> 8, g = (job >> 6) & 3, part = (job >> 5) & 1, kb = job & 31;
            LAS float* Wc = (LAS float*)L; LAS float* Bp = Wc + 64 * 128;
            __syncthreads();
            for (int i = tid; i < 64 * 32; i += NTHREADS) { const int row = i >> 5, c4 = (i & 31) * 4; *(LAS f32x4*)(Wc + row * 128 + c4) = *(const f32x4*)(w_in + ((size_t)l * DM + kb * 64 + row) * 3584 + 1536 + g * 128 + c4); }
            const float* bsrc = BF + ((size_t)((l * 2 + part) * 4 + g) * 128) * 128;
            for (int i = tid; i < 128 * 32; i += NTHREADS) *(LAS f32x4*)(Bp + i * 4) = *(const f32x4*)(bsrc + i * 4);
            __syncthreads();
            const int d4 = tid & 31, kg = tid >> 5;
            f32x4 acc[4];
#pragma unroll
            for (int i = 0; i < 4; ++i) acc[i] = (f32x4){0.f, 0.f, 0.f, 0.f};
#pragma unroll 4
            for (int c = 0; c < 128; ++c) { const f32x4 bv = *(const LAS f32x4*)(Bp + c * 128 + 4 * d4);
#pragma unroll
                for (int i = 0; i < 4; ++i) acc[i] += bv * Wc[(4 * kg + i) * 128 + c]; }
#pragma unroll
            for (int e = 0; e < 4; ++e) { u32x2 o; o.x = pk2(acc[0][e], acc[1][e]); o.y = pk2(acc[2][e], acc[3][e]);
                *(u32x2*)(WIN + (size_t)l * WIN_ROWS * DM + (size_t)(3072 + part * 512 + g * 128 + 4 * d4 + e) * DM + kb * 64 + 4 * kg) = o; }
        }
        __syncthreads();
        LAS float* va = (LAS float*)L;
        for (int i = tid; i < 2 * DM; i += NTHREADS) { const int v = i >> 11, c = i & (DM - 1); va[(v * 2 + 0) * DM + c] = g_pre_mix[c] * (1.0f + modp(ws, 0, v, 1)[c]); va[(v * 2 + 1) * DM + c] = modp(ws, 0, v, 0)[c]; }
        __syncthreads();
        for (int row = gw; row < MR; row += NGW) {
            const int v = row >= NLAT; const float* src = v ? ctx_in + (size_t)(row - NLAT) * DM : x_in + (size_t)row * DM;
            f32x4 xv[8]; ld_row_f32_nt(src, lane, xv);
            const float r = __builtin_amdgcn_rsqf(row_sumsq(xv) * (1.0f / DM) + EPS);
            const LAS f32x4* A = (const LAS f32x4*)(va + (v * 2) * DM) + lane; const LAS f32x4* B = (const LAS f32x4*)(va + (v * 2 + 1) * DM) + lane;
#pragma unroll
            for (int j = 0; j < 8; ++j) xv[j] = xv[j] * r * A[64 * j] + B[64 * j];
            st_row_bf16(H + (size_t)row * DM, lane, xv);
        }
    }
    SEAM(1);
    for (int l = 0; l < 2; ++l) {
        const int PB = 2 + l * 10;
        bf16_t* WINl = WIN + (size_t)l * WIN_ROWS * DM; bf16_t* WOUTl = WOUT + (size_t)l * DM * DM;
        const int nrows = l == 0 ? MR : NLAT;
        const float lambda_init = l == 0 ? 0.2f : 0.35550906759096927f;

        if (IN(PB + 0)) for (int rep_ = 0; rep_ < REP_K0; ++rep_) {
#ifndef NO_G0
            { pg8::Gemm g{H, WINl, DM, DM, DM}; pg8::SchedIn S{G, bx, 0, 0};
              pg8::EpiBf16 E{P, PC, P, PC};
              pg8::gemm_phase<pg8::EpiBf16, pg8::SchedIn, true>(L, g, S, E); }
#endif
#ifndef NO_G1
            { pg8::Gemm g{WINl + (size_t)3072 * DM, H, DM, 16 * DM, DM}; pg8::SchedZW S{G, (bx + G / 2) % G};
              pg8::EpiBf16 E{ZWT, 16384, ZWTC, 512};
              pg8::gemm_phase<pg8::EpiBf16, pg8::SchedZW, true>(L, g, S, E); }
#endif
            { PHASE_LOCALS
              const bf16_t* Hc = H + (size_t)NLAT * DM; bf16_t* Pc = P + (size_t)NLAT * PC;
              if (l == 0) {
                            pg8::ctx_gemm<0>(Hc, DM, WINl, DM, DM, 48, 0, Pc, PC, 0, L, tid, vcu, G);
                            pg8::ctx_gemm<2>(Hc, DM, WINl, DM, DM, 16, 3072, ZWTC, 512, 0, L, tid, (vcu + 64) % G, G);
              } else {
                            pg8::ctx_gemm<0>(Hc, DM, WINl, DM, DM, 24, 1536, Pc, PC, 1536, L, tid, vcu, G);
              }
            }
        }
        SEAM(PB + 0);

        if (IN(PB + 1)) {
            PHASE_LOCALS
            const int sub = lane >> 3, t = lane & 7;
            for (int row = gw; row < MR; row += NGW) {
                const bool is_lat = row < NLAT; const int prow = row >> 6, pcol = row & 63;
                bf16_t* pr = P + (size_t)row * PC;
#pragma unroll 1
                for (int pass = 0; pass < 3; ++pass) {
                    const int seg = pass * 8 + sub;
                    if (seg >= 18) continue;
                    if (l == 1 && !is_lat && seg < 12) continue;
                    const bool typeA = seg < 8 || (seg >= 12 && seg < 14), isq = seg < 12;
                    const int col0 = seg < 8 ? PC_QA + seg * 128 : seg < 12 ? PC_QB + (seg - 8) * 128 : seg < 14 ? PC_KA + (seg - 12) * 128 : PC_KB + (seg - 14) * 128;
                    int cA_, cB_, jb; bool is_col; float fmul;
                    if (typeA) { cA_ = t < 4 ? t : t + 4; cB_ = cA_ + 4; jb = (t & 3) * 8; is_col = t >= 4; fmul = -0.41524101186092029f; }
                    else { const int v = t >> 2, tt = t & 3; const int cc = tt < 2 ? tt : tt + 2; cA_ = v * 8 + cc; cB_ = cA_ + 2; jb = (tt & 1) * 8; is_col = tt >= 2; fmul = -0.83048202372184059f; }
                    u32x4 wa = *(const u32x4*)(pr + col0 + cA_ * 8), wb = *(const u32x4*)(pr + col0 + cB_ * 8);
                    float xa[8], xb[8];
                    xa[0] = bf_lo(wa.x); xa[1] = bf_hi(wa.x); xa[2] = bf_lo(wa.y); xa[3] = bf_hi(wa.y); xa[4] = bf_lo(wa.z); xa[5] = bf_hi(wa.z); xa[6] = bf_lo(wa.w); xa[7] = bf_hi(wa.w);
                    xb[0] = bf_lo(wb.x); xb[1] = bf_hi(wb.x); xb[2] = bf_lo(wb.y); xb[3] = bf_hi(wb.y); xb[4] = bf_lo(wb.z); xb[5] = bf_hi(wb.z); xb[6] = bf_lo(wb.w); xb[7] = bf_hi(wb.w);
                    if (typeA) {
                        float ss = 0.f;
#pragma unroll
                        for (int i = 0; i < 8; ++i) ss += xa[i] * xa[i] + xb[i] * xb[i];
                        ss += __shfl_xor(ss, 1); ss += __shfl_xor(ss, 2); ss += __shfl_xor(ss, 4);
                        const float r = __builtin_amdgcn_rsqf(ss * (1.0f / 128.0f) + EPS);
                        const float* gv = (seg < 8 ? g_q_a : g_k_a) + l * 128;
#pragma unroll
                        for (int i = 0; i < 8; ++i) { xa[i] *= r * gv[cA_ * 8 + i]; xb[i] *= r * gv[cB_ * 8 + i]; }
                    }
                    if (is_lat) {
                        const float pos = (float)(is_col ? pcol : prow);
#pragma unroll
                        for (int i = 0; i < 8; ++i) { const float fr = __builtin_amdgcn_exp2f((float)(jb + i) * fmul); const float rev = pos * fr * 0.15915494309189535f;
                            const float cs = __builtin_amdgcn_cosf(rev), sn = __builtin_amdgcn_sinf(rev); const float a = xa[i], b = xb[i]; xa[i] = a * cs - b * sn; xb[i] = b * cs + a * sn; }
                    }
                    if (isq) { const float cq = typeA ? 0.12751743082459868f : 0.18033688011112042f;
#pragma unroll
                        for (int i = 0; i < 8; ++i) { xa[i] *= cq; xb[i] *= cq; } }
                    wa.x = pk2(xa[0], xa[1]); wa.y = pk2(xa[2], xa[3]); wa.z = pk2(xa[4], xa[5]); wa.w = pk2(xa[6], xa[7]);
                    wb.x = pk2(xb[0], xb[1]); wb.y = pk2(xb[2], xb[3]); wb.z = pk2(xb[4], xb[5]); wb.w = pk2(xb[6], xb[7]);
                    if (isq || typeA || is_lat) { *(u32x4*)(pr + col0 + cA_ * 8) = wa; *(u32x4*)(pr + col0 + cB_ * 8) = wb; }
                }
            }
        }
        SEAM(PB + 1);

        if (IN(PB + 2)) for (int rep_ = 0; rep_ < REP_K2; ++rep_) {
            PHASE_LOCALS
            const int nctxu = l == 0 ? 8 : 0;
#define MOE_CONVERT() do { if (G % 2 == 0) { LAS float* scr_ = (LAS float*)(L + wave * 16640); \
          \
        const int ib_ = (1 + 4 * l) * J_FFN, ie_ = (5 + 4 * l) * J_FFN; const bool skew_ = G == 256; const int nall_ = skew_ ? 37 : (4 * J_FFN + NGW - 1) / NGW, nown_ = nall_ + ((skew_ && bx < 128) ? 10 : 0); \
        for (int r_ = 0; r_ < nown_; ++r_) { const int it_ = ib_ + (r_ < nall_ ? r_ * NGW + gw : nall_ * NGW + (r_ - nall_) * (NGW / 2) + bx * NWAVES + wave); if (it_ >= ie_) break; \
            ffn_weight_item(it_ / J_FFN, it_ % J_FFN, w_gate_d, w_up_d, w_down_d, w_gate_m, w_up_m, w_down_m, WGU, WDN, MGU, MDN, scr_, lane); } \
        __syncthreads(); } } while (0)
            if (vcu % 3 == 0) MOE_CONVERT();
#ifndef NO_ATTA
            for (int U = vcu; U < 256 + nctxu; U += G) {
                const bool isc = U >= 256; const int head = isc ? U - 256 : U >> 5, qrow = isc ? NLAT : (U & 31) * 256, krow = isc ? NLAT : 0, seq = isc ? NCTX : MR;
                att::attn_unit<128, false, PC>((const att::bf16*)(P + (size_t)qrow * PC + PC_QA + head * 128), (const att::bf16*)(P + (size_t)krow * PC + PC_KA + (head >> 2) * 128),
                    (const att::bf16*)(P + (size_t)krow * PC + PC_VA + (head >> 2) * 128), (void*)(Y + (size_t)qrow * DM + head * 128), DM, seq, 0, (char*)lds);
            }
#endif
            if (vcu % 3 == 1) MOE_CONVERT();
#ifndef NO_ATTB
            for (int U = vcu; U < 256 + nctxu; U += G) {
                const bool isc = U >= 256; const int hc = isc ? U - 256 : U >> 5, head = hc >> 1, comp = hc & 1, qrow = isc ? NLAT : (U & 31) * 256, krow = isc ? NLAT : 0, seq = isc ? NCTX : MR;
                att::attn_unit<64, false, PC>((const att::bf16*)(P + (size_t)qrow * PC + PC_QB + head * 128 + comp * 64), (const att::bf16*)(P + (size_t)krow * PC + PC_KB + head * 128),
                    (const att::bf16*)(P + (size_t)krow * PC + PC_VB + head * 128), (void*)(DIFFO + (size_t)comp * MR * 512 + (size_t)qrow * 512 + head * 128), 512, seq, comp * 64, (char*)lds);
            }
#endif
            if (vcu % 3 == 2) MOE_CONVERT();
#undef MOE_CONVERT
#ifndef NO_GEMM
            { pg8::Gemm g{DFT, ZWT, 1024, 16384, 1024}; pg8::SchedF1 S{G, (bx + G / 2) % G};
              pg8::EpiBf16 E{Y1, 512, Y1, 512};
              pg8::gemm_phase<pg8::EpiBf16, pg8::SchedF1, true>(L, g, S, E); }
#endif
        }
        SEAM(PB + 2);

        if (IN(PB + 3)) {
            PHASE_LOCALS
            const float lam = __expf(wave_sum(lq1[l * 64 + lane] * lk1[l * 64 + lane])) - __expf(wave_sum(lq2[l * 64 + lane] * lk2[l * 64 + lane])) + lambda_init;
            const float g0 = g_subln[l * 128 + 2 * lane] * (1.0f - lambda_init), g1 = g_subln[l * 128 + 2 * lane + 1] * (1.0f - lambda_init);
            for (int row = gw; row < nrows; row += NGW) {
#pragma unroll
                for (int h = 0; h < 4; ++h) {
                    const unsigned u1_ = *(const unsigned*)(DIFFO + (size_t)row * 512 + h * 128 + 2 * lane), u2_ = *(const unsigned*)(DIFFO + (size_t)MR * 512 + (size_t)row * 512 + h * 128 + 2 * lane);
                    const float2 o1 = {bf_lo(u1_), bf_hi(u1_)}, o2 = {bf_lo(u2_), bf_hi(u2_)};
                    const float d0 = o1.x - lam * o2.x, d1 = o1.y - lam * o2.y;
                    const float r = __builtin_amdgcn_rsqf(wave_sum(d0 * d0 + d1 * d1) * (1.0f / 128.0f) + EPS);
                    *(unsigned*)(Y + (size_t)row * DM + 1024 + h * 128 + 2 * lane) = pk2(d0 * r * g0, d1 * r * g1);
                }
            }
            for (int item = gw; item < 2048; item += NGW) {
                const int k1 = item >> 2, qf = item & 3;
                f32x4 a0[4], a1[4];
#pragma unroll
                for (int j = 0; j < 4; ++j) { a0[j] = (f32x4){0.f, 0.f, 0.f, 0.f}; a1[j] = (f32x4){0.f, 0.f, 0.f, 0.f}; }
#pragma unroll 2
                for (int n2 = 0; n2 < 16; ++n2) {
                    const u32x4 wr_ = *(const u32x4*)(Y1 + ((size_t)n2 * 1024 + k1) * 512 + 8 * lane), wi_ = *(const u32x4*)(Y1 + ((size_t)n2 * 1024 + 512 + k1) * 512 + 8 * lane);
                    const f32x4 r0 = {bf_lo(wr_.x), bf_hi(wr_.x), bf_lo(wr_.y), bf_hi(wr_.y)}, r1 = {bf_lo(wr_.z), bf_hi(wr_.z), bf_lo(wr_.w), bf_hi(wr_.w)};
                    const f32x4 i0 = {bf_lo(wi_.x), bf_hi(wi_.x), bf_lo(wi_.y), bf_hi(wi_.y)}, i1 = {bf_lo(wi_.z), bf_hi(wi_.z), bf_lo(wi_.w), bf_hi(wi_.w)};
#pragma unroll
                    for (int j = 0; j < 4; ++j) { const int kk = k1 + 512 * (4 * qf + j); const float ph = (float)((n2 * kk) & 8191) * (1.0f / 8192.0f);
                        const float cs = __builtin_amdgcn_cosf(ph), sn = __builtin_amdgcn_sinf(ph);
                        a0[j] += r0 * cs + i0 * sn; a1[j] += r1 * cs + i1 * sn; }
                }
#pragma unroll
                for (int j = 0; j < 4; ++j) { const int kk = k1 + 512 * (4 * qf + j);
                    u32x4 w; w.x = pk2(a0[j].x, a0[j].y); w.y = pk2(a0[j].z, a0[j].w); w.z = pk2(a1[j].x, a1[j].y); w.w = pk2(a1[j].z, a1[j].w);
                    *(u32x4*)(Y + (size_t)kk * DM + 1536 + 8 * lane) = w; }
            }
            if (l == 0) {
                for (int idx = vcu * NTHREADS + tid; idx < NCTX * 512; idx += G * NTHREADS) {
                    const int k = idx >> 9, d = idx & 511; const u32x4* a = (const u32x4*)(DFTC + (size_t)k * 512); const u32x4* b = (const u32x4*)(ZWTC + (size_t)d * 512);
                    float s = 0.f;
#pragma unroll 16
                    for (int i = 0; i < 64; ++i) { const u32x4 wa = a[i], wb = b[i];
                        s += bf_lo(wa.x) * bf_lo(wb.x) + bf_hi(wa.x) * bf_hi(wb.x) + bf_lo(wa.y) * bf_lo(wb.y) + bf_hi(wa.y) * bf_hi(wb.y)
                           + bf_lo(wa.z) * bf_lo(wb.z) + bf_hi(wa.z) * bf_hi(wb.z) + bf_lo(wa.w) * bf_lo(wb.w) + bf_hi(wa.w) * bf_hi(wb.w); }
                    Y[(size_t)(NLAT + k) * DM + 1536 + d] = (bf16_t)(pk2(s, 0.f) & 0xffffu);
                }
            }
        }
        SEAM(PB + 3);

        if (IN(PB + 4)) for (int rep_ = 0; rep_ < REP_K4; ++rep_) {
            pg8::Gemm g{Y, WOUTl, DM, DM, DM}; pg8::SchedTiles S{32, 8, 256, G, bx, DM, DM, 256};
            pg8::EpiBf16 E{O, DM, O, DM};
#ifndef NO_G4
            pg8::gemm_phase<pg8::EpiBf16, pg8::SchedTiles, true>(L, g, S, E);
#endif
            if (l == 0) { PHASE_LOCALS
                pg8::ctx_gemm<0>(Y + (size_t)NLAT * DM, DM, WOUTl, DM, DM, 32, 0, O + (size_t)NLAT * DM, DM, 0, L, tid, vcu, G);
            }
        }
        SEAM(PB + 4);

        if (IN(PB + 5)) {
            PHASE_LOCALS
            LAS float* vv = (LAS float*)L;
            LAS float* wr = vv + 6 * DM;
            LAS int* lcnt = (LAS int*)(L + LDSCTL_OFF + 2048);
            __syncthreads();
            for (int i = tid; i < 2 * DM; i += NTHREADS) { const int v = i >> 11, c = i & (DM - 1);
                vv[(v * 3 + 0) * DM + c] = modp(ws, l, v, 2)[c] * g_post_mix[l * DM + c];
                vv[(v * 3 + 1) * DM + c] = g_pre_ffn[l * DM + c] * (1.0f + modp(ws, l, v, 4)[c]);
                vv[(v * 3 + 2) * DM + c] = modp(ws, l, v, 3)[c]; }
            if (l == 1) { for (int i = tid; i < DM * 8 / 4; i += NTHREADS) ((LAS f32x4*)wr)[i] = ((const f32x4*)w_router)[i]; if (tid < 8) lcnt[tid] = 0; }
            __syncthreads();
            for (int rep5_ = 0; rep5_ < (l == 0 ? REP_K5 : 1); ++rep5_)
            for (int row = gw; row < nrows; row += NGW) {
                const int v = row >= NLAT;
                const float* xs = l == 0 ? (v ? ctx_in + (size_t)(row - NLAT) * DM : x_in + (size_t)row * DM) : X + (size_t)row * DM;
                f32x4 ov[8], xv[8]; ld_row_bf16(O + (size_t)row * DM, lane, ov); ld_row_f32_nt(xs, lane, xv);
                const float r1 = __builtin_amdgcn_rsqf(row_sumsq(ov) * (1.0f / DM) + EPS);
                const LAS f32x4* GG = (const LAS f32x4*)(vv + (v * 3 + 0) * DM) + lane; const LAS f32x4* A2 = (const LAS f32x4*)(vv + (v * 3 + 1) * DM) + lane; const LAS f32x4* B2 = (const LAS f32x4*)(vv + (v * 3 + 2) * DM) + lane;
#pragma unroll
                for (int j = 0; j < 8; ++j) xv[j] = xv[j] + ov[j] * r1 * GG[64 * j];
                st_row_f32_nt(X + (size_t)row * DM, lane, xv);
                const float r2 = __builtin_amdgcn_rsqf(row_sumsq(xv) * (1.0f / DM) + EPS);
#pragma unroll
                for (int j = 0; j < 8; ++j) xv[j] = xv[j] * r2 * A2[64 * j] + B2[64 * j];
                st_row_bf16(H + (size_t)row * DM, lane, xv);
                if (l == 1) {
                    float lg[8];
#pragma unroll
                    for (int e = 0; e < 8; ++e) lg[e] = 0.f;
#pragma unroll
                    for (int j = 0; j < 8; ++j)
#pragma unroll
                        for (int i = 0; i < 4; ++i) { const int col = 4 * lane + 256 * j + i; const f32x4 w0 = *(const LAS f32x4*)(wr + col * 8), w1 = *(const LAS f32x4*)(wr + col * 8 + 4); const float hv = xv[j][i];
                            lg[0] += hv * w0.x; lg[1] += hv * w0.y; lg[2] += hv * w0.z; lg[3] += hv * w0.w; lg[4] += hv * w1.x; lg[5] += hv * w1.y; lg[6] += hv * w1.z; lg[7] += hv * w1.w; }
#pragma unroll
                    for (int e = 0; e < 8; ++e) lg[e] = wave_sum(lg[e]);
                    int i0 = 0; float m0 = lg[0];
#pragma unroll
                    for (int e = 1; e < 8; ++e) if (lg[e] > m0) { m0 = lg[e]; i0 = e; }
                    int i1 = -1; float m1 = -INFINITY;
#pragma unroll
                    for (int e = 0; e < 8; ++e) if (e != i0 && lg[e] > m1) { m1 = lg[e]; i1 = e; }
                    const float ex = __expf(m1 - m0); const float w0 = 1.0f / (1.0f + ex), w1 = ex / (1.0f + ex);
                    if (lane == 0) { const int r0 = __hip_atomic_fetch_add(&lcnt[i0], 1, __ATOMIC_RELAXED, __HIP_MEMORY_SCOPE_WORKGROUP), r1_ = __hip_atomic_fetch_add(&lcnt[i1], 1, __ATOMIC_RELAXED, __HIP_MEMORY_SCOPE_WORKGROUP);
                        u32x4 ta; ta.x = (unsigned)i0; ta.y = (unsigned)i1; ta.z = (unsigned)r0; ta.w = (unsigned)r1_; *(u32x4*)(TOK + (size_t)row * 8) = ta;
                        TOK[(size_t)row * 8 + 4] = __float_as_uint(w0); TOK[(size_t)row * 8 + 5] = __float_as_uint(w1); }
                }
            }
            if (l == 1) { __syncthreads(); if (tid < 8) WGCNT[vcu * 8 + tid] = lcnt[tid]; }
        }
        SEAM(PB + 5);

        if (l == 1) {
            if (IN(PB + 6)) {
                PHASE_LOCALS
                moe_tables(ws, L + LDSCTL_OFF, L, true, G);
                const LAS int* T = (const LAS int*)(L + LDSCTL_OFF);
                for (int row = gw; row < NLAT; row += NGW) {
                    const u32x4 ta = *(const u32x4*)(TOK + (size_t)row * 8);
                    const int p0 = T[256 + vcu * 8 + (int)ta.x] + (int)ta.z, p1 = T[256 + vcu * 8 + (int)ta.y] + (int)ta.w;
                    if (lane == 0) { TOK[(size_t)row * 8 + 6] = (unsigned)p0; TOK[(size_t)row * 8 + 7] = (unsigned)p1; }
                    const u32x4* src = (const u32x4*)(H + (size_t)row * DM); u32x4* d0 = (u32x4*)(HS + (size_t)p0 * DM); u32x4* d1 = (u32x4*)(HS + (size_t)p1 * DM);
#pragma unroll
                    for (int j = 0; j < 4; ++j) { const u32x4 w = __builtin_nontemporal_load(src + lane + 64 * j); d0[lane + 64 * j] = w; d1[lane + 64 * j] = w; }
                }
                for (int e = 0; e < 8; ++e) { const int st = T[e] + T[16 + e], en = T[e + 1];
                    for (int r = st + gw; r < en; r += NGW) { u32x4* d0 = (u32x4*)(HS + (size_t)r * DM);
#pragma unroll
                        for (int j = 0; j < 4; ++j) d0[lane + 64 * j] = (u32x4){0u, 0u, 0u, 0u}; } }
            }
            SEAM(PB + 6);
        }

        if (IN(PB + 7) || IN(PB + 8)) {
            PHASE_LOCALS
            LAS int* T = (LAS int*)(L + LDSCTL_OFF);
            if (l == 0) { __syncthreads(); if (tid < 72) T[64 + tid] = 0; if (tid == 0) T[32] = NLAT / 256; __syncthreads(); }
            else moe_tables(ws, L + LDSCTL_OFF, L, false, G);
        }
        if (IN(PB + 7)) for (int rep_ = 0; rep_ < REP_K7; ++rep_) {
            const LAS int* T = (const LAS int*)(L + LDSCTL_OFF);
            pg8::Gemm g{l == 0 ? H : HS, l == 0 ? WGU : MGU, DM, DM, DM};
            const int units7 = T[32] * 56, left7 = units7 - (units7 / G) * G; const bool wide7 = l == 1 && left7 > 0 && left7 <= WIDE_MAX;
            pg8::SchedMoe S{T[32], 56, G, bx, DM, DM, 128, (long)2 * DFF * DM, T + 64, wide7 ? units7 - left7 : 1 << 30};
            pg8::EpiSwiglu E{l == 0 ? ACT : MACT, DFF};
#ifndef NO_G7
            pg8::gemm_phase<pg8::EpiSwiglu, pg8::SchedMoe, true>(L, g, S, E);
#endif
            { PHASE_LOCALS
              if (l == 0) pg8::ctx_gemm_wide<1>(H + (size_t)NLAT * DM, DM, WGU, DM, DM, 224, 1, ACT + (size_t)NLAT * DFF, DFF, L, tid, vcu, G);
              else if (wide7) pg8::ctx_gemm_wide<1>(HS, DM, MGU, DM, DM, 0, 0, MACT, DFF, L, tid, vcu, G, T + 64, T[32], units7 - left7, (long)2 * DFF * DM, left7);
            }
        }
        SEAM(PB + 7);
        if (IN(PB + 8)) for (int rep_ = 0; rep_ < REP_K8; ++rep_) {
            const LAS int* T = (const LAS int*)(L + LDSCTL_OFF);
            pg8::Gemm g{l == 0 ? ACT : MACT, l == 0 ? WDN : MDN, DFF, DFF, DFF};
            const int dn_first = 2 * G;
            pg8::SchedMoe S{T[32], 8, G, bx, DFF, DFF, 256, (long)DM * DFF, T + 64, dn_first};
            pg8::EpiBf16 E{l == 0 ? O : DOUT, DM, O, DM};
#ifndef NO_G8
            pg8::gemm_phase<pg8::EpiBf16, pg8::SchedMoe, true>(L, g, S, E);
#endif
            if (l == 1 && T[32] * 8 > dn_first) {
                const int R = T[32] * 8 - dn_first;
                const int nsl = 14 * R <= G ? 14 : 8 * R <= G ? 8 : 7 * R <= G ? 7 : 4;
                if (threadIdx.x == 0) for (int Lt = bx; Lt < nsl * R; Lt += G) if (Lt % nsl == 0) { int p_, pn_; pg8::moe_map(dn_first + Lt / nsl, T[32], 8, p_, pn_); ctl[CW_TAIL + p_ * 8 + pn_] = ((unsigned)(Lt / nsl) + 1u) | ((unsigned)nsl << 16); }
                pg8::Gemm g2{MACT, MDN, DFF, DFF, DFF / nsl}; pg8::SchedMoeTail S2{T[32], 8, G, bx, DFF, DFF, (long)DM * DFF, T + 64, dn_first, DFF / nsl, nsl};
                pg8::EpiF32 E2{(float*)(ws + WS_PART), 256};
                pg8::gemm_phase<pg8::EpiF32, pg8::SchedMoeTail, true>(L, g2, S2, E2);
            }
            if (l == 0) { PHASE_LOCALS
                pg8::ctx_gemm_wide<3>(ACT + (size_t)NLAT * DFF, DFF, WDN, DFF, DFF / 7, 32, 7, ws + WS_PART, DM, L, tid, vcu, G);
            }
        }
        SEAM(PB + 8);

        if (IN(PB + 9)) {
            PHASE_LOCALS
            LAS float* vv = (LAS float*)L;
            __syncthreads();
            for (int i = tid; i < 2 * DM; i += NTHREADS) { const int v = i >> 11, c = i & (DM - 1);
                vv[(v * 3 + 0) * DM + c] = modp(ws, l, v, 5)[c] * g_post_ffn[l * DM + c];
                if (l == 0) { vv[(v * 3 + 1) * DM + c] = g_pre_mix[DM + c] * (1.0f + modp(ws, 1, v, 1)[c]); vv[(v * 3 + 2) * DM + c] = modp(ws, 1, v, 0)[c]; } }
            __syncthreads();
            for (int row = gw; row < nrows; row += NGW) {
                const int v = row >= NLAT;
                f32x4 ov[8], xv[8];
                if (l == 0) {
                    if (v) { const float* cp = (const float*)(ws + WS_PART) + (size_t)(row - NLAT) * DM;
                        ld_row_f32(cp, lane, ov);
                        for (int ks = 1; ks < 7; ++ks) { f32x4 t_[8]; ld_row_f32(cp + (size_t)ks * NCTX * DM, lane, t_);
#pragma unroll
                            for (int j = 0; j < 8; ++j) ov[j] += t_[j]; } }
                    else ld_row_bf16(O + (size_t)row * DM, lane, ov); }
                else { const unsigned p0 = TOK[(size_t)row * 8 + 6], p1 = TOK[(size_t)row * 8 + 7]; const float w0 = __uint_as_float(TOK[(size_t)row * 8 + 4]), w1 = __uint_as_float(TOK[(size_t)row * 8 + 5]);
                    f32x4 o1[8]; ld_row_bf16(DOUT + (size_t)p0 * DM, lane, ov); ld_row_bf16(DOUT + (size_t)p1 * DM, lane, o1);
                    const float* PART = (const float*)(ws + WS_PART);
                    const u32x4* tf0 = (const u32x4*)(ctl + CW_TAIL + (p0 >> 8) * 8); const u32x4* tf1 = (const u32x4*)(ctl + CW_TAIL + (p1 >> 8) * 8);
                    const u32x4 f0a = tf0[0], f0b = tf0[1], f1a = tf1[0], f1b = tf1[1];
                    if ((f0a.x | f0a.y | f0a.z | f0a.w | f0b.x | f0b.y | f0b.z | f0b.w | f1a.x | f1a.y | f1a.z | f1a.w | f1b.x | f1b.y | f1b.z | f1b.w) != 0u) {
#pragma unroll
                        for (int j = 0; j < 8; ++j) {
                            const unsigned t0 = __builtin_amdgcn_readfirstlane(j < 4 ? f0a[j & 3] : f0b[j & 3]), t1 = __builtin_amdgcn_readfirstlane(j < 4 ? f1a[j & 3] : f1b[j & 3]);
                            if (t0) { const int ns_ = (int)(t0 >> 16), ub_ = (int)((t0 & 0xffffu) - 1u) * ns_; f32x4 a = {0.f, 0.f, 0.f, 0.f}; for (int ks = 0; ks < ns_; ++ks) a += *(const f32x4*)(PART + ((size_t)(ub_ + ks) * 256 + (p0 & 255)) * 256 + 4 * lane); ov[j] = a; }
                            if (t1) { const int ns_ = (int)(t1 >> 16), ub_ = (int)((t1 & 0xffffu) - 1u) * ns_; f32x4 a = {0.f, 0.f, 0.f, 0.f}; for (int ks = 0; ks < ns_; ++ks) a += *(const f32x4*)(PART + ((size_t)(ub_ + ks) * 256 + (p1 & 255)) * 256 + 4 * lane); o1[j] = a; }
                        }
                    }
#pragma unroll
                    for (int j = 0; j < 8; ++j) ov[j] = ov[j] * w0 + o1[j] * w1; }
                ld_row_f32_nt(X + (size_t)row * DM, lane, xv);
                const float r1 = __builtin_amdgcn_rsqf(row_sumsq(ov) * (1.0f / DM) + EPS);
                const LAS f32x4* GG = (const LAS f32x4*)(vv + (v * 3 + 0) * DM) + lane;
#pragma unroll
                for (int j = 0; j < 8; ++j) xv[j] = xv[j] + ov[j] * r1 * GG[64 * j];
                if (l == 0) {
                    st_row_f32_nt(X + (size_t)row * DM, lane, xv);
                    const LAS f32x4* A2 = (const LAS f32x4*)(vv + (v * 3 + 1) * DM) + lane; const LAS f32x4* B2 = (const LAS f32x4*)(vv + (v * 3 + 2) * DM) + lane;
                    const float r2 = __builtin_amdgcn_rsqf(row_sumsq(xv) * (1.0f / DM) + EPS);
#pragma unroll
                    for (int j = 0; j < 8; ++j) xv[j] = xv[j] * r2 * A2[64 * j] + B2[64 * j];
                    st_row_bf16(H + (size_t)row * DM, lane, xv);
                } else st_row_f32_nt(args.out + (size_t)row * DM, lane, xv);
            }
        }
        if (l == 0) SEAM(PB + 9);
    }
#undef IN
#undef SEAM
}

extern "C" void kernel_launch(void* const* d_in, const int* in_sizes, int n_in, void* d_out, int out_size, void* d_ws, size_t ws_size, hipStream_t stream) {
    static int grid = 0;
    if (grid == 0) {
        if (n_in != 27 || out_size != NLAT * DM || ws_size < WS_END) { fprintf(stderr, "kernel_launch: unexpected shapes (n_in %d out %d ws %zu)\n", n_in, out_size, ws_size); grid = -1; return; }
        int dev = 0, cus = 0, per_cu = 0;
        if (hipGetDevice(&dev) != hipSuccess || hipDeviceGetAttribute(&cus, hipDeviceAttributeMultiprocessorCount, dev) != hipSuccess) { grid = -1; return; }
        if (hipFuncSetAttribute((const void*)fwd_kernel, hipFuncAttributeMaxDynamicSharedMemorySize, LDS_BYTES) != hipSuccess) { fprintf(stderr, "kernel_launch: hipFuncSetAttribute failed\n"); grid = -1; return; }
        if (hipOccupancyMaxActiveBlocksPerMultiprocessor(&per_cu, (const void*)fwd_kernel, NTHREADS, LDS_BYTES) != hipSuccess || per_cu < 1) { fprintf(stderr, "kernel_launch: occupancy query says %d\n", per_cu); (void)hipGetLastError(); per_cu = 1; }
        grid = cus > 256 ? 256 : cus;
    }
    if (grid < 0) return;
    (void)hipMemsetAsync((char*)d_ws + WS_CTL, 0, CTL_ZERO_BYTES, stream);
    Args a{};
    for (int i = 0; i < 27; ++i) a.in[i] = (const float*)d_in[i];
    a.out = (float*)d_out; a.ws = (unsigned char*)d_ws; a.ph_lo = 0; a.ph_hi = 1000;
    hipLaunchKernelGGL(fwd_kernel, dim3(grid), dim3(NTHREADS), LDS_BYTES, stream, a);
}
```

```cpp
#include <hip/hip_runtime.h>
#include <hip/hip_bf16.h>
#include <cstdio>
#include <cstdint>
#include <cmath>
namespace pg8 {
#define PG8_LAS __attribute__((address_space(3)))
typedef unsigned short bf16_t;
typedef short bf16x8 __attribute__((ext_vector_type(8)));
typedef float f32x4 __attribute__((ext_vector_type(4)));
typedef unsigned u32x4 __attribute__((ext_vector_type(4)));
constexpr int BM = 256, BK = 64, HALF = 128, HTB = HALF * BK * 2, STAGE_BYTES = 8 * HTB, NXCD = 8, WGM = 8;

__host__ __device__ __forceinline__ int lds_byte(int r, int c) { const int st = (r >> 4) * 2 + (c >> 5), rr = r & 15, cc = c & 31, ob = rr * 64 + cc * 2; return st * 1024 + (ob ^ (((ob >> 9) & 1) << 5)); }
__host__ __device__ __forceinline__ void stage_rc(int b, int& R, int& C) { const int st = b / 1024, sb = b % 1024, swz = sb ^ (((sb >> 9) & 1) << 5); R = (st >> 1) * 16 + swz / 64; C = (st & 1) * 32 + (swz % 64) / 2; }
__host__ __device__ __forceinline__ int perm32(int rho) { const int n = rho >> 4, i = rho & 15; return 8 * (i >> 2) + 4 * n + (i & 3); }

struct Unit { long aoff, boff; int orow, ocol, sel; };
struct Gemm { const bf16_t* A; const bf16_t* Bt; int lda, ldb, K; };

typedef float f32x2_t __attribute__((ext_vector_type(2))); typedef __bf16 bf16x2_t __attribute__((ext_vector_type(2)));
__device__ __forceinline__ unsigned cvt_pk_bf16(float lo, float hi) { f32x2_t v = {lo, hi}; bf16x2_t b = __builtin_convertvector(v, bf16x2_t); return __builtin_bit_cast(unsigned, b); }

template <bool XSW> __device__ __forceinline__ f32x4 xsw4(f32x4 v, int fq) {
    if (!XSW) return v; const bool o = (fq & 1) != 0; return (f32x4){o ? v[1] : v[0], o ? v[0] : v[1], o ? v[3] : v[2], o ? v[2] : v[3]}; }
template <bool XSW = false> struct EpiBf16T {
    static constexpr bool PERM = true;
    bf16_t* O0; int ldc0; bf16_t* O1; int ldc1;
    template <class UU> __device__ __forceinline__ void operator()(const f32x4 (&acc)[2][2][4][2], const UU& u, int wr, int wc, int fr, int fq) const {
        bf16_t* O = u.sel ? O1 : O0; const int ldc = u.sel ? ldc1 : ldc0;
        const int row0 = u.orow + wr * 64 + fr, col0 = u.ocol + wc * 32 + 8 * fq;
#pragma unroll
        for (int ai = 0; ai < 2; ++ai)
#pragma unroll
            for (int m = 0; m < 4; ++m) { bf16_t* rowp = O + (size_t)(row0 + ai * HALF + m * 16) * ldc + col0;
#pragma unroll
                for (int bj = 0; bj < 2; ++bj) { const f32x4 v0 = xsw4<XSW>(acc[ai][bj][m][0], fq), v1 = xsw4<XSW>(acc[ai][bj][m][1], fq);
                    u32x4 w; w.x = cvt_pk_bf16(v0[0], v0[1]); w.y = cvt_pk_bf16(v0[2], v0[3]); w.z = cvt_pk_bf16(v1[0], v1[1]); w.w = cvt_pk_bf16(v1[2], v1[3]);
                    *(u32x4*)(rowp + bj * HALF) = w; } }
    }
};
typedef EpiBf16T<false> EpiBf16;
__device__ __forceinline__ float silu_mul(float g, float u) { return g * u * __builtin_amdgcn_rcpf(1.0f + __builtin_amdgcn_exp2f(-1.4426950408889634f * g)); }
template <bool XSW = false> struct EpiSwigluT {
    static constexpr bool PERM = true;
    bf16_t* O; int ldc;
    template <class UU> __device__ __forceinline__ void operator()(const f32x4 (&acc)[2][2][4][2], const UU& u, int wr, int wc, int fr, int fq) const {
        const int row0 = u.orow + wr * 64 + fr, col0 = u.ocol + wc * 32 + 8 * fq;
#pragma unroll
        for (int ai = 0; ai < 2; ++ai)
#pragma unroll
            for (int m = 0; m < 4; ++m) { bf16_t* rowp = O + (size_t)(row0 + ai * HALF + m * 16) * ldc + col0;
                const f32x4 g0 = xsw4<XSW>(acc[ai][0][m][0], fq), g1 = xsw4<XSW>(acc[ai][0][m][1], fq), u0 = xsw4<XSW>(acc[ai][1][m][0], fq), u1 = xsw4<XSW>(acc[ai][1][m][1], fq);
                u32x4 w; w.x = cvt_pk_bf16(silu_mul(g0[0], u0[0]), silu_mul(g0[1], u0[1])); w.y = cvt_pk_bf16(silu_mul(g0[2], u0[2]), silu_mul(g0[3], u0[3]));
                w.z = cvt_pk_bf16(silu_mul(g1[0], u1[0]), silu_mul(g1[1], u1[1])); w.w = cvt_pk_bf16(silu_mul(g1[2], u1[2]), silu_mul(g1[3], u1[3]));
                *(u32x4*)rowp = w; }
    }
};
typedef EpiSwigluT<false> EpiSwiglu;
struct EpiF32 {
    static constexpr bool PERM = false;
    float* O; int ldc;
    template <class UU> __device__ __forceinline__ void operator()(const f32x4 (&acc)[2][2][4][2], const UU& u, int wr, int wc, int fr, int fq) const {
        const int row0 = u.orow + wr * 64 + fr, col0 = u.ocol + wc * 32 + 4 * fq;
#pragma unroll
        for (int ai = 0; ai < 2; ++ai)
#pragma unroll
            for (int m = 0; m < 4; ++m) { float* rowp = O + (size_t)(row0 + ai * HALF + m * 16) * ldc + col0;
#pragma unroll
                for (int bj = 0; bj < 2; ++bj)
#pragma unroll
                    for (int n = 0; n < 2; ++n) *(f32x4*)(rowp + bj * HALF + n * 16) = acc[ai][bj][m][n]; }
    }
};

template <class Epi, class Sched, bool ALIGN_EPI, bool KBLK = false>
__device__ __forceinline__ void gemm_phase(PG8_LAS unsigned char* lds, const Gemm g, const Sched& S, const Epi& E) {
    int tid_ = threadIdx.x; asm volatile("" : "+v"(tid_));
    const int tid = tid_, wid = __builtin_amdgcn_readfirstlane(tid >> 6), lane = tid & 63, wr = wid >> 2, wc = wid & 3, fr = lane & 15, fq = lane >> 4;
    const int K = g.K, nt = K / BK;
    unsigned voffA[2], voffB[2];
#pragma unroll
    for (int i = 0; i < 2; ++i) { int R, C; stage_rc(tid * 16 + i * 8192, R, C); const int Rb = Epi::PERM ? ((R & ~31) + perm32(R & 31)) : R;
        voffA[i] = (unsigned)(R * g.lda + C) * 2u; voffB[i] = KBLK ? (unsigned)((C >> 3) * g.ldb + Rb) * 16u : (unsigned)(Rb * g.ldb + C) * 2u; }
    const size_t kstep = (size_t)(BK * 2);
    const size_t hstepA = (size_t)HALF * g.lda * 2, hstepB = KBLK ? (size_t)HALF * 16 : (size_t)HALF * g.ldb * 2;
    const size_t kstepB = KBLK ? (size_t)8 * g.ldb * 16 : kstep;
    const unsigned ldsw = (unsigned)wid * 1024u;
    const int aoff = lds_byte(wr * 64 + fr, fq * 8), boff = lds_byte(wc * 32 + fr, fq * 8);
#define PG8_SA(b, h) (((b) * 2 + (h)) * HTB)
#define PG8_SB(b, h) ((4 + (b) * 2 + (h)) * HTB)
#define PG8_STAGE(bufoff, gbase, voff) do { _Pragma("unroll") for (int _i = 0; _i < 2; ++_i) \
        __builtin_amdgcn_global_load_lds((const unsigned*)((const char*)(gbase) + (voff)[_i]), (PG8_LAS unsigned*)(lds + (bufoff) + ldsw + _i * 8192), 16, 0, 0); } while (0)
#define PG8_LDA(dst, b, h) do { _Pragma("unroll") for (int m = 0; m < 4; ++m) _Pragma("unroll") for (int k = 0; k < 2; ++k) dst[m][k] = *(const PG8_LAS bf16x8*)(lds + PG8_SA(b, h) + aoff + m * 2048 + k * 1024); } while (0)
#define PG8_LDB(dst, b, h) do { _Pragma("unroll") for (int n = 0; n < 2; ++n) _Pragma("unroll") for (int k = 0; k < 2; ++k) dst[n][k] = *(const PG8_LAS bf16x8*)(lds + PG8_SB(b, h) + boff + n * 2048 + k * 1024); } while (0)
#define PG8_MMA(ai, bj, At, Bt) do { __builtin_amdgcn_s_setprio(1); _Pragma("unroll") for (int m = 0; m < 4; ++m) _Pragma("unroll") for (int n = 0; n < 2; ++n) _Pragma("unroll") for (int k = 0; k < 2; ++k) \
        acc[ai][bj][m][n] = __builtin_amdgcn_mfma_f32_16x16x32_bf16(Bt[n][k], At[m][k], acc[ai][bj][m][n], 0, 0, 0); __builtin_amdgcn_s_setprio(0); } while (0)
#define PG8_WAIT_V(n) asm volatile("s_waitcnt vmcnt(" #n ")" ::: "memory")
#define PG8_WAIT_L(n) asm volatile("s_waitcnt lgkmcnt(" #n ")" ::: "memory")
#define PG8_BAR __builtin_amdgcn_s_barrier()
#define PG8_SCHED __builtin_amdgcn_sched_barrier(0)
    Unit cur, nxt; int ui = 0;
    if (!S.next(0, cur)) return;
    f32x4 acc[2][2][4][2];
#pragma unroll
    for (int a = 0; a < 2; ++a)
#pragma unroll
        for (int b = 0; b < 2; ++b)
#pragma unroll
            for (int m = 0; m < 4; ++m)
#pragma unroll
                for (int n = 0; n < 2; ++n) acc[a][b][m][n] = (f32x4){0.f, 0.f, 0.f, 0.f};
    bf16x8 At[4][2], B0[2][2], B1[2][2];
    const char* cA = (const char*)g.A + (size_t)cur.aoff * 2; const char* cB = (const char*)g.Bt + (size_t)cur.boff * 2;
    PG8_STAGE(PG8_SB(0, 0), cB, voffB); PG8_STAGE(PG8_SB(0, 1), cB + hstepB, voffB); PG8_STAGE(PG8_SA(0, 0), cA, voffA); PG8_STAGE(PG8_SA(0, 1), cA + hstepA, voffA);
    if (wr == 1) PG8_BAR;
    PG8_WAIT_V(2); PG8_BAR;
    PG8_STAGE(PG8_SB(1, 0), cB + kstepB, voffB); PG8_STAGE(PG8_SA(1, 0), cA + kstep, voffA); PG8_STAGE(PG8_SB(1, 1), cB + hstepB + kstepB, voffB);
    PG8_WAIT_V(6); PG8_BAR;
    for (;;) {
        const bool has_next = S.next(ui + 1, nxt);
        const char* nA = has_next ? (const char*)g.A + (size_t)nxt.aoff * 2 : cA; const char* nB = has_next ? (const char*)g.Bt + (size_t)nxt.boff * 2 : cB;
        for (int t = 0; t < nt; t += 2) {
            const bool last = (t == nt - 2);
            const char* a1 = cA + (size_t)(t + 1) * kstep;
            const char* a2 = last ? nA : cA + (size_t)(t + 2) * kstep; const char* b2 = last ? nB : cB + (size_t)(t + 2) * kstepB;
            const char* a3 = a2 + kstep; const char* b3 = b2 + kstepB;
            PG8_LDB(B0, 0, 0); PG8_LDB(B1, 0, 1); PG8_SCHED; PG8_LDA(At, 0, 0); PG8_STAGE(PG8_SA(1, 1), a1 + hstepA, voffA);
            PG8_WAIT_V(8); PG8_WAIT_L(0); PG8_BAR; PG8_MMA(0, 0, At, B0); PG8_MMA(0, 1, At, B1); PG8_BAR; PG8_SCHED;
            PG8_LDA(At, 0, 1); PG8_STAGE(PG8_SB(0, 0), b2, voffB); PG8_STAGE(PG8_SB(0, 1), b2 + hstepB, voffB); PG8_STAGE(PG8_SA(0, 0), a2, voffA);
            PG8_WAIT_V(8); PG8_WAIT_L(0); PG8_BAR; PG8_MMA(1, 0, At, B0); PG8_MMA(1, 1, At, B1); PG8_BAR; PG8_SCHED;
            PG8_LDB(B0, 1, 0); PG8_LDB(B1, 1, 1); PG8_SCHED; PG8_LDA(At, 1, 0); PG8_STAGE(PG8_SA(0, 1), a2 + hstepA, voffA);
            PG8_WAIT_V(8); PG8_WAIT_L(0); PG8_BAR; PG8_MMA(0, 0, At, B0); PG8_MMA(0, 1, At, B1); PG8_BAR; PG8_SCHED;
            PG8_LDA(At, 1, 1); PG8_STAGE(PG8_SB(1, 0), b3, voffB); PG8_STAGE(PG8_SB(1, 1), b3 + hstepB, voffB); PG8_STAGE(PG8_SA(1, 0), a3, voffA);
            PG8_WAIT_V(8); PG8_WAIT_L(0); PG8_BAR; PG8_MMA(1, 0, At, B0); PG8_MMA(1, 1, At, B1); PG8_BAR; PG8_SCHED;
        }
        if constexpr (ALIGN_EPI) { if (wr == 0) PG8_BAR; }
        E(acc, cur, wr, wc, fr, fq);
        if (!has_next) break;
#pragma unroll
        for (int a = 0; a < 2; ++a)
#pragma unroll
            for (int b = 0; b < 2; ++b)
#pragma unroll
                for (int m = 0; m < 4; ++m)
#pragma unroll
                    for (int n = 0; n < 2; ++n) acc[a][b][m][n] = (f32x4){0.f, 0.f, 0.f, 0.f};
        cur = nxt; cA = nA; cB = nB; ++ui;
        if constexpr (ALIGN_EPI) { if (wr == 1) PG8_BAR; }
    }
    PG8_WAIT_V(0);
    if constexpr (!ALIGN_EPI) { if (wr == 0) PG8_BAR; }
    PG8_BAR;
#undef PG8_SA
#undef PG8_SB
#undef PG8_STAGE
#undef PG8_LDA
#undef PG8_LDB
#undef PG8_MMA
#undef PG8_WAIT_V
#undef PG8_WAIT_L
#undef PG8_BAR
#undef PG8_SCHED
}

struct SchedIn {
    int G, c, nextra, pn0;
    __device__ __forceinline__ bool next(int i, Unit& u) const {
        const int L = i * G + c; int pm, pn;
        if (L < 384) { constexpr int nwg = 384, nN = 12, nM = 32;
            int wgid = L; { const int q = nwg / NXCD, r = nwg % NXCD, xcd = wgid % NXCD, off = wgid / NXCD; wgid = (xcd < r ? xcd * (q + 1) : r * (q + 1) + (xcd - r) * q) + off; }
            const int nig = WGM * nN, gid = wgid / nig, fm = gid * WGM, gsz = (nM - fm) < WGM ? (nM - fm) : WGM;
            pm = fm + ((wgid % nig) % gsz); pn = (wgid % nig) / gsz;
        } else { const int j = L - 384; if (j >= nextra) return false; pm = 32; pn = pn0 + j; }
        u.aoff = (long)pm * BM * 2048; u.boff = (long)pn * BM * 2048; u.orow = pm * BM; u.ocol = pn * BM; u.sel = 0; return true;
    }
};
struct SchedZW {
    int G, c;
    __device__ __forceinline__ bool next(int i, Unit& u) const {
        const int L = i * G + c; if (L >= 128) return false;
        const int pm = L & 3, pn = L >> 2, n2 = pn >> 1, h = pn & 1;
        u.aoff = (long)pm * BM * 2048; u.boff = (long)(4096 * h + n2) * 2048; u.orow = (pm & 1) * BM; u.ocol = n2 * 1024 + (pm >> 1) * 512 + h * 256; u.sel = 0; return true;
    }
};
struct SchedTiles {
    int nM, nN, nwg, G, c, lda, ldb, ocw;
    __device__ __forceinline__ bool next(int i, Unit& u) const {
        const int L = i * G + c; if (L >= nwg) return false;
        int wgid = L; { const int q = nwg / NXCD, r = nwg % NXCD, xcd = wgid % NXCD, off = wgid / NXCD; wgid = (xcd < r ? xcd * (q + 1) : r * (q + 1) + (xcd - r) * q) + off; }
        const int nig = WGM * nN, gid = wgid / nig, fm = gid * WGM, gsz = (nM - fm) < WGM ? (nM - fm) : WGM;
        const int pm = fm + ((wgid % nig) % gsz), pn = (wgid % nig) / gsz;
        u.aoff = (long)pm * BM * lda; u.boff = (long)pn * BM * ldb; u.orow = pm * BM; u.ocol = pn * ocw; u.sel = 0; return true;
    }
};
struct SchedF1 {
    int G, c;
    __device__ __forceinline__ bool next(int i, Unit& u) const {
        const int L = i * G + c; if (L >= 128) return false;
        const int n2 = L >> 3, mt = (L >> 1) & 3, dt = L & 1;
        u.aoff = (long)mt * BM * 1024; u.boff = (long)dt * BM * 16384 + n2 * 1024; u.orow = n2 * 1024 + mt * BM; u.ocol = dt * BM; u.sel = 0; return true;
    }
};
__device__ __forceinline__ void moe_map(int L, int npan, int nN, int& p, int& pn) {
    const int nwg = npan * nN;
    int wgid = L; { const int q = nwg / NXCD, r = nwg % NXCD, xcd = wgid % NXCD, off = wgid / NXCD; wgid = (xcd < r ? xcd * (q + 1) : r * (q + 1) + (xcd - r) * q) + off; }
    const int nig = WGM * nN, gid = wgid / nig, fm = gid * WGM, gsz = (npan - fm) < WGM ? (npan - fm) : WGM;
    p = fm + ((wgid % nig) % gsz); pn = (wgid % nig) / gsz;
}
struct SchedMoe {
    int npan, nN, G, c, lda, ldb, ocw; long estride; const PG8_LAS int* pe; int lim;
    __device__ __forceinline__ bool next(int i, Unit& u) const {
        const int L = i * G + c; const int nwg = npan * nN; if (L >= nwg || L >= lim) return false;
        int p, pn; moe_map(L, npan, nN, p, pn); const int e = pe[p];
        u.aoff = (long)p * BM * lda; u.boff = (long)e * estride + (long)pn * BM * ldb; u.orow = p * BM; u.ocol = pn * ocw; u.sel = 0; return true;
    }
};
struct SchedMoeTail {
    int npan, nN, G, c, lda, ldb; long estride; const PG8_LAS int* pe; int first, ksl, nsl;
    __device__ __forceinline__ bool next(int i, Unit& u) const {
        const int Lt = i * G + c; const int R = npan * nN - first; if (Lt >= nsl * R) return false;
        const int un = Lt / nsl, ks = Lt - un * nsl;
        int p, pn; moe_map(first + un, npan, nN, p, pn); const int e = pe[p];
        u.aoff = (long)p * BM * lda + ks * ksl; u.boff = (long)e * estride + (long)pn * BM * ldb + ks * ksl; u.orow = Lt * BM; u.ocol = 0; u.sel = 0; return true;
    }
};

template <int EPI, bool KBLK = false>
__device__ __forceinline__ void ctx_gemm(const bf16_t* __restrict__ A, int lda, const bf16_t* __restrict__ Bt, int ldb, int K, int ntn, int brow0,
                                         bf16_t* __restrict__ O, int ldo, int ocol0, PG8_LAS unsigned char* lds, int tid, int vcu, int G) {
    typedef unsigned u32x2_ __attribute__((ext_vector_type(2)));
    constexpr int LROW = 144;
    const int lane = tid & 63, w = __builtin_amdgcn_readfirstlane(tid >> 6), fr = lane & 15, fq = lane >> 4, mb = w >> 1, h = w & 1;
    const int srow = tid >> 3, skc = (tid & 7) * 8;
    const int nb0 = (EPI == 1) ? h : 2 * h, nb1 = (EPI == 1) ? 2 + h : 2 * h + 1;
    for (int tile = vcu; tile < 4 * ntn; tile += G) {
        const int tm = tile & 3, tn = tile >> 2;
        int brow;
        if (EPI == 1) brow = (tn >> 2) * 256 + (tn & 3) * 32 + (srow < 32 ? srow : 128 + srow - 32); else brow = brow0 + tn * 64 + srow;
        const bf16_t* ga = A + (size_t)(tm * 64 + srow) * lda + skc;
        const bf16_t* gb = KBLK ? Bt + ((size_t)(skc >> 3) * ldb + brow) * 8 : Bt + (size_t)brow * ldb + skc;
        const size_t bch = KBLK ? (size_t)64 * ldb : 64;
        f32x4 acc0 = {0.f, 0.f, 0.f, 0.f}, acc1 = {0.f, 0.f, 0.f, 0.f};
        constexpr int PD = 8;
        u32x4 ra[PD], rb[PD];
#pragma unroll
        for (int j = 0; j < PD; ++j) { ra[j] = *(const u32x4*)(ga + (size_t)j * 64); rb[j] = *(const u32x4*)(gb + (size_t)j * bch); }
        const int nch = K / 64;
        __syncthreads();
        for (int c = 0; c < nch; c += PD) {
#pragma unroll
            for (int j = 0; j < PD; ++j) {
                PG8_LAS unsigned char* sa = lds + (j & 1) * (2 * 64 * LROW); PG8_LAS unsigned char* sb = sa + 64 * LROW;
                *(PG8_LAS u32x4*)(sa + srow * LROW + skc * 2) = ra[j]; *(PG8_LAS u32x4*)(sb + srow * LROW + skc * 2) = rb[j];
                __syncthreads();
                if (c + j + PD < nch) { ra[j] = *(const u32x4*)(ga + (size_t)(c + j + PD) * 64); rb[j] = *(const u32x4*)(gb + (size_t)(c + j + PD) * bch); }
#pragma unroll
                for (int ks = 0; ks < 2; ++ks) {
                    const bf16x8 af = *(const PG8_LAS bf16x8*)(sa + (mb * 16 + fr) * LROW + (ks * 32 + fq * 8) * 2);
                    const bf16x8 b0 = *(const PG8_LAS bf16x8*)(sb + (nb0 * 16 + fr) * LROW + (ks * 32 + fq * 8) * 2);
                    const bf16x8 b1 = *(const PG8_LAS bf16x8*)(sb + (nb1 * 16 + fr) * LROW + (ks * 32 + fq * 8) * 2);
                    acc0 = __builtin_amdgcn_mfma_f32_16x16x32_bf16(b0, af, acc0, 0, 0, 0);
                    acc1 = __builtin_amdgcn_mfma_f32_16x16x32_bf16(b1, af, acc1, 0, 0, 0);
                }
            }
        }
        const int row = tm * 64 + mb * 16 + fr;
        if (EPI == 0) {
            u32x2_ w0, w1; w0.x = cvt_pk_bf16(acc0[0], acc0[1]); w0.y = cvt_pk_bf16(acc0[2], acc0[3]); w1.x = cvt_pk_bf16(acc1[0], acc1[1]); w1.y = cvt_pk_bf16(acc1[2], acc1[3]);
            bf16_t* op = O + (size_t)row * ldo + ocol0 + tn * 64 + 4 * fq;
            *(u32x2_*)(op + nb0 * 16) = w0; *(u32x2_*)(op + nb1 * 16) = w1;
        } else if (EPI == 1) {
            u32x2_ wv; wv.x = cvt_pk_bf16(silu_mul(acc0[0], acc1[0]), silu_mul(acc0[1], acc1[1])); wv.y = cvt_pk_bf16(silu_mul(acc0[2], acc1[2]), silu_mul(acc0[3], acc1[3]));
            *(u32x2_*)(O + (size_t)row * ldo + tn * 32 + h * 16 + 4 * fq) = wv;
        } else {
#pragma unroll
            for (int i = 0; i < 4; ++i) { const int d0 = tn * 64 + nb0 * 16 + 4 * fq + i, d1 = tn * 64 + nb1 * 16 + 4 * fq + i;
                O[(size_t)(d0 & 511) * 512 + (d0 >> 9) * 256 + row] = (bf16_t)(cvt_pk_bf16(acc0[i], 0.f) & 0xffffu);
                O[(size_t)(d1 & 511) * 512 + (d1 >> 9) * 256 + row] = (bf16_t)(cvt_pk_bf16(acc1[i], 0.f) & 0xffffu); }
        }
    }
    __syncthreads();
}

template <int EPI>
__device__ __forceinline__ void ctx_gemm_wide(const bf16_t* __restrict__ A, int lda, const bf16_t* __restrict__ Bt, int ldb, int Ks, int ntn, int nks,
                                              void* __restrict__ Ov, int ldo, PG8_LAS unsigned char* lds, int tid, int vcu, int G,
                                              const PG8_LAS int* pe = nullptr, int npan = 0, int first = 0, long estride = 0, int nleft = 0) {
    typedef unsigned u32x2_ __attribute__((ext_vector_type(2)));
    constexpr int LROW = 144;
    const int lane = tid & 63, w = __builtin_amdgcn_readfirstlane(tid >> 6), fr = lane & 15, fq = lane >> 4;
    const int srow = tid >> 3, skc = (tid & 7) * 8;
    const int nitems = pe ? 4 * nleft : ntn * nks;
    for (int item = vcu; item < nitems; item += G) {
        int tn, ks; const bf16_t* Ai = A; const bf16_t* Bi = Bt; void* Oi = Ov;
        if (pe) { int p_, pn_; moe_map(first + (item >> 2), npan, 56, p_, pn_); tn = pn_ * 4 + (item & 3); ks = 0;
                  Ai = A + (size_t)p_ * 256 * lda; Bi = Bt + (size_t)pe[p_] * estride; Oi = (bf16_t*)Ov + (size_t)p_ * 256 * ldo; }
        else { tn = item % ntn; ks = item / ntn; }
        const int brow = (EPI == 1) ? (tn >> 2) * 256 + (tn & 3) * 32 + (srow < 32 ? srow : 128 + srow - 32) : tn * 64 + srow;
        const bf16_t* ga = Ai + (size_t)srow * lda + (size_t)ks * Ks + skc;
        const bf16_t* gb = Bi + (size_t)brow * ldb + (size_t)ks * Ks + skc;
        f32x4 acc[2][4];
#pragma unroll
        for (int mi = 0; mi < 2; ++mi)
#pragma unroll
            for (int nb = 0; nb < 4; ++nb) acc[mi][nb] = (f32x4){0.f, 0.f, 0.f, 0.f};
        constexpr int PD = 4;
        u32x4 ra[PD][4], rb[PD];
#pragma unroll
        for (int j = 0; j < PD; ++j) {
#pragma unroll
            for (int q = 0; q < 4; ++q) ra[j][q] = *(const u32x4*)(ga + (size_t)(64 * q) * lda + (size_t)j * 64);
            rb[j] = *(const u32x4*)(gb + (size_t)j * 64); }
        const int nch = Ks / 64;
        __syncthreads();
#define CW_WRITE(slot, buf) do { PG8_LAS unsigned char* sa_ = lds + (buf) * (320 * LROW); PG8_LAS unsigned char* sb_ = sa_ + 256 * LROW; \
            _Pragma("unroll") for (int q = 0; q < 4; ++q) *(PG8_LAS u32x4*)(sa_ + (srow + 64 * q) * LROW + skc * 2) = ra[slot][q]; \
            *(PG8_LAS u32x4*)(sb_ + srow * LROW + skc * 2) = rb[slot]; } while (0)
#define CW_LOAD(slot, ch) do { _Pragma("unroll") for (int q = 0; q < 4; ++q) ra[slot][q] = *(const u32x4*)(ga + (size_t)(64 * q) * lda + (size_t)(ch) * 64); \
            rb[slot] = *(const u32x4*)(gb + (size_t)(ch) * 64); } while (0)
        CW_WRITE(0, 0); if (PD < nch) CW_LOAD(0, PD);
        __syncthreads();
        for (int c = 0; c < nch; c += PD) {
#pragma unroll
            for (int j = 0; j < PD; ++j) {
                const int cc = c + j;
                PG8_LAS unsigned char* sa = lds + (j & 1) * (320 * LROW); PG8_LAS unsigned char* sb = sa + 256 * LROW;
                bf16x8 af[2][2], bfr[2][4];
#pragma unroll
                for (int kst = 0; kst < 2; ++kst) {
#pragma unroll
                    for (int mi = 0; mi < 2; ++mi) af[kst][mi] = *(const PG8_LAS bf16x8*)(sa + ((2 * w + mi) * 16 + fr) * LROW + (kst * 32 + fq * 8) * 2);
#pragma unroll
                    for (int nb = 0; nb < 4; ++nb) bfr[kst][nb] = *(const PG8_LAS bf16x8*)(sb + (nb * 16 + fr) * LROW + (kst * 32 + fq * 8) * 2);
                }
                __builtin_amdgcn_sched_barrier(0);
                if (cc + 1 < nch) { CW_WRITE((j + 1) % PD, (j + 1) & 1); if (cc + 1 + PD < nch) CW_LOAD((j + 1) % PD, cc + 1 + PD); }
                __builtin_amdgcn_sched_barrier(0);
#pragma unroll
                for (int kst = 0; kst < 2; ++kst)
#pragma unroll
                    for (int mi = 0; mi < 2; ++mi)
#pragma unroll
                        for (int nb = 0; nb < 4; ++nb) acc[mi][nb] = __builtin_amdgcn_mfma_f32_16x16x32_bf16(bfr[kst][nb], af[kst][mi], acc[mi][nb], 0, 0, 0);
                __syncthreads();
            }
        }
#undef CW_WRITE
#undef CW_LOAD
#pragma unroll
        for (int mi = 0; mi < 2; ++mi) { const int row = (2 * w + mi) * 16 + fr;
            if (EPI == 1) {
#pragma unroll
                for (int hh = 0; hh < 2; ++hh) { u32x2_ wv; wv.x = cvt_pk_bf16(silu_mul(acc[mi][hh][0], acc[mi][2 + hh][0]), silu_mul(acc[mi][hh][1], acc[mi][2 + hh][1]));
                    wv.y = cvt_pk_bf16(silu_mul(acc[mi][hh][2], acc[mi][2 + hh][2]), silu_mul(acc[mi][hh][3], acc[mi][2 + hh][3]));
                    *(u32x2_*)((bf16_t*)Oi + (size_t)row * ldo + tn * 32 + hh * 16 + 4 * fq) = wv; }
            } else {
#pragma unroll
                for (int nb = 0; nb < 4; ++nb) *(f32x4*)((float*)Oi + ((size_t)ks * 256 + row) * ldo + tn * 64 + nb * 16 + 4 * fq) = acc[mi][nb];
            }
        }
    }
    __syncthreads();
}

}
namespace att {
using bf16 = __hip_bfloat16;
constexpr int D = 128, NW = 8, QBLK = 32, KVBLK = 64;
constexpr float THR = 8.f;
constexpr size_t SHM_V = KVBLK * D * 2, SHM_K = KVBLK * D * 2, SHM_ATTN = 2 * SHM_V + 2 * SHM_K + NW * 64 * 4;
using bf16x8 = __attribute__((ext_vector_type(8))) short;
using s16x4  = __attribute__((ext_vector_type(4))) short;
using f32x16 = __attribute__((ext_vector_type(16))) float;
using u32x4  = __attribute__((ext_vector_type(4))) unsigned;
#define KSWZ(row, colB) ((row) * 256 + ((colB) ^ (((row) & 7) << 4)))
#define SBAR() __builtin_amdgcn_sched_barrier(0)
__device__ __forceinline__ int crow(int r, int hi) { return (r & 3) + 8 * (r >> 2) + 4 * hi; }
__device__ __forceinline__ unsigned cvtpk(float lo, float hi) { unsigned r; asm volatile("v_cvt_pk_bf16_f32 %0, %1, %2" : "=v"(r) : "v"(lo), "v"(hi)); return r; }

__device__ __forceinline__ void expHalf(f32x16& p) { for (int r = 0; r < 16; ++r) p[r] = __builtin_amdgcn_exp2f(p[r]); }
__device__ __forceinline__ void finishSM(f32x16& p0, f32x16& p1, float& l_reg, bf16x8& pa0, bf16x8& pa1, bf16x8& pa2, bf16x8& pa3) {
  for (int r = 0; r < 16; ++r) p1[r] = __builtin_amdgcn_exp2f(p1[r]);
  float ps = 0; for (int r = 0; r < 16; ++r) ps += p0[r]; for (int r = 0; r < 16; ++r) ps += p1[r];
  l_reg += ps;
#define PK4(P, BASE, OUT) do { unsigned a0 = cvtpk(P[BASE + 0], P[BASE + 1]), a1 = cvtpk(P[BASE + 2], P[BASE + 3]);   \
    unsigned b0 = cvtpk(P[BASE + 4], P[BASE + 5]), b1 = cvtpk(P[BASE + 6], P[BASE + 7]);                              \
    auto r0 = __builtin_amdgcn_permlane32_swap(a0, b0, false, false); auto r1 = __builtin_amdgcn_permlane32_swap(a1, b1, false, false); \
    u32x4 w = {r0[0], r1[0], r0[1], r1[1]}; OUT = *reinterpret_cast<bf16x8*>(&w); } while (0)
  PK4(p0, 0, pa0); PK4(p0, 8, pa1); PK4(p1, 0, pa2); PK4(p1, 8, pa3);
#undef PK4
}
template <int DQK>
__device__ __forceinline__ void qkt(f32x16& p0, f32x16& p1, const bf16* Ks, const bf16x8* qr, int r32, int hi, int kcol) {
  p0 = f32x16{}; p1 = f32x16{};
#pragma unroll
  for (int d0 = 0; d0 < DQK / 16; ++d0) { int cb = (kcol + d0 * 16 + hi * 8) * 2;
    bf16x8 b0 = *reinterpret_cast<const bf16x8*>((const char*)Ks + KSWZ(r32, cb));
    bf16x8 b1 = *reinterpret_cast<const bf16x8*>((const char*)Ks + KSWZ(32 + r32, cb));
    p0 = __builtin_amdgcn_mfma_f32_32x32x16_bf16(b0, qr[d0], p0, 0, 0, 0);
    p1 = __builtin_amdgcn_mfma_f32_32x32x16_bf16(b1, qr[d0], p1, 0, 0, 0); }
}
__device__ __forceinline__ int v_st(int k, int c) { const int kk = (k & ~0xC) | ((k & 4) << 1) | ((k & 8) >> 1); return ((kk >> 3) * 4 + (c >> 5)) * 512 + ((kk & 7) * 32 + (c & 31)) * 2; }
__device__ __forceinline__ int v_rd_base(int lane) { return ((lane & 3) << 3) | (((lane >> 2) & 3) << 6) | (((lane >> 4) & 1) << 5) | (((lane >> 5) & 1) << 8); }
constexpr int v_rd_off(int d0, int ks, int half) { return d0 * 512 + ks * 4096 + half * 2048; }
template <int OFF> __device__ __forceinline__ s16x4 tr_read(int vb) {
  s16x4 r; asm volatile("ds_read_b64_tr_b16 %0, %1 offset:%2" : "=&v"(r) : "v"(vb), "i"(OFF) : "memory"); return r;
}
template <int D0> __device__ __forceinline__ void pv_one(f32x16& od, int vb, bf16x8 pa0, bf16x8 pa1, bf16x8 pa2, bf16x8 pa3) {
  const s16x4 l0 = tr_read<v_rd_off(D0, 0, 0)>(vb), h0 = tr_read<v_rd_off(D0, 0, 1)>(vb), l1 = tr_read<v_rd_off(D0, 1, 0)>(vb), h1 = tr_read<v_rd_off(D0, 1, 1)>(vb);
  const s16x4 l2 = tr_read<v_rd_off(D0, 2, 0)>(vb), h2 = tr_read<v_rd_off(D0, 2, 1)>(vb), l3 = tr_read<v_rd_off(D0, 3, 0)>(vb), h3 = tr_read<v_rd_off(D0, 3, 1)>(vb);
  asm volatile("s_waitcnt lgkmcnt(0)" ::: "memory"); SBAR();
#define PK(L, H) (bf16x8){L[0], L[1], L[2], L[3], H[0], H[1], H[2], H[3]}
  od = __builtin_amdgcn_mfma_f32_32x32x16_bf16(pa0, PK(l0, h0), od, 0, 0, 0);
  od = __builtin_amdgcn_mfma_f32_32x32x16_bf16(pa1, PK(l1, h1), od, 0, 0, 0);
  od = __builtin_amdgcn_mfma_f32_32x32x16_bf16(pa2, PK(l2, h2), od, 0, 0, 0);
  od = __builtin_amdgcn_mfma_f32_32x32x16_bf16(pa3, PK(l3, h3), od, 0, 0, 0);
#undef PK
}
__device__ __forceinline__ void pv_d0_exp(f32x16* o, int vb, bf16x8 pa0, bf16x8 pa1, bf16x8 pa2, bf16x8 pa3, f32x16& pe) {
  { const s16x4 l0 = tr_read<v_rd_off(0, 0, 0)>(vb), h0 = tr_read<v_rd_off(0, 0, 1)>(vb), l1 = tr_read<v_rd_off(0, 1, 0)>(vb), h1 = tr_read<v_rd_off(0, 1, 1)>(vb);
    const s16x4 l2 = tr_read<v_rd_off(0, 2, 0)>(vb), h2 = tr_read<v_rd_off(0, 2, 1)>(vb), l3 = tr_read<v_rd_off(0, 3, 0)>(vb), h3 = tr_read<v_rd_off(0, 3, 1)>(vb);
    SBAR(); expHalf(pe); SBAR();
    asm volatile("s_waitcnt lgkmcnt(0)" ::: "memory"); SBAR();
#define PK(L, H) (bf16x8){L[0], L[1], L[2], L[3], H[0], H[1], H[2], H[3]}
    o[0] = __builtin_amdgcn_mfma_f32_32x32x16_bf16(pa0, PK(l0, h0), o[0], 0, 0, 0);
    o[0] = __builtin_amdgcn_mfma_f32_32x32x16_bf16(pa1, PK(l1, h1), o[0], 0, 0, 0);
    o[0] = __builtin_amdgcn_mfma_f32_32x32x16_bf16(pa2, PK(l2, h2), o[0], 0, 0, 0);
    o[0] = __builtin_amdgcn_mfma_f32_32x32x16_bf16(pa3, PK(l3, h3), o[0], 0, 0, 0);
#undef PK
  }
  pv_one<1>(o[1], vb, pa0, pa1, pa2, pa3); pv_one<2>(o[2], vb, pa0, pa1, pa2, pa3); pv_one<3>(o[3], vb, pa0, pa1, pa2, pa3);
}
__device__ __forceinline__ void pv_d0(f32x16* o, int vb, bf16x8 pa0, bf16x8 pa1, bf16x8 pa2, bf16x8 pa3) {
  pv_one<0>(o[0], vb, pa0, pa1, pa2, pa3); pv_one<1>(o[1], vb, pa0, pa1, pa2, pa3); pv_one<2>(o[2], vb, pa0, pa1, pa2, pa3); pv_one<3>(o[3], vb, pa0, pa1, pa2, pa3);
}

template <int DQK, bool OF32, int LDP>
__device__ __forceinline__ void attn_unit(const bf16* __restrict__ Qb, const bf16* __restrict__ Kh, const bf16* __restrict__ Vh, void* __restrict__ Ob, int ldo, int seq, int kcol, char* lds) {
  int tid_ = threadIdx.x; asm volatile("" : "+v"(tid_));
  const int tid = tid_, wid = tid >> 6, lane = tid & 63, r32 = lane & 31, hi = lane >> 5;
  bf16* V_lds = (bf16*)lds; bf16* K_lds = (bf16*)(lds + 2 * SHM_V);
  float* ws = (float*)(lds + 2 * SHM_V + 2 * SHM_K) + wid * 64; float* li_l = ws;
  float l_reg = 0; f32x16 o[4] = {}; bf16x8 qr[DQK / 16];
  const bf16* Qw = Qb + (long)(wid * QBLK + r32) * LDP + hi * 8;
#pragma unroll
  for (int d0 = 0; d0 < DQK / 16; ++d0) qr[d0] = *reinterpret_cast<const bf16x8*>(Qw + d0 * 16);
  const int sr = tid >> 4, sc = (tid & 15) * 8, vst0 = v_st(sr, sc), vst1 = v_st(32 + sr, sc);
  const int vb0 = (int)(uintptr_t)V_lds + v_rd_base(lane);
  struct { bf16x8 vs0, vs1, ks0, ks1; } sr_[1];
#define SLOAD(i, k0) do { sr_[i].vs0 = *reinterpret_cast<const bf16x8*>(&Vh[(long)((k0) + sr) * LDP + sc]); sr_[i].vs1 = *reinterpret_cast<const bf16x8*>(&Vh[(long)((k0) + 32 + sr) * LDP + sc]); \
    sr_[i].ks0 = *reinterpret_cast<const bf16x8*>(&Kh[(long)((k0) + sr) * LDP + sc]); sr_[i].ks1 = *reinterpret_cast<const bf16x8*>(&Kh[(long)((k0) + 32 + sr) * LDP + sc]); } while (0)
#define SWRITE(b, i) do { *(bf16x8*)((char*)V_lds + (b) * SHM_V + vst0) = sr_[i].vs0;          \
    *(bf16x8*)((char*)V_lds + (b) * SHM_V + vst1) = sr_[i].vs1; int kc = sc * 2;               \
    *(bf16x8*)((char*)K_lds + (b) * SHM_K + KSWZ(sr, kc)) = sr_[i].ks0;                       \
    *(bf16x8*)((char*)K_lds + (b) * SHM_K + KSWZ(32 + sr, kc)) = sr_[i].ks1; } while (0)
#define SWAIT() asm volatile("s_waitcnt vmcnt(0)" ::: "memory")
  f32x16 pA0, pA1, pB0, pB1; bf16x8 pa0, pa1, pa2, pa3; const int NT = seq / KVBLK;
  constexpr int SE = 0, SO = 0;
  if (__builtin_amdgcn_readfirstlane(tid) >= 256) __builtin_amdgcn_s_setprio(1);
  SLOAD(SE, 0); asm volatile("s_waitcnt vmcnt(0)" ::: "memory"); SWRITE(0, SE); __syncthreads();
  qkt<DQK>(pA0, pA1, K_lds, qr, r32, hi, kcol); SBAR(); expHalf(pA0); SBAR();
  SLOAD(SO, KVBLK);
  SWAIT(); SWRITE(1, SO); __syncthreads();
  for (int j = 1; j + 1 < NT; j += 2) {
    SLOAD(SO, (j + 1) * KVBLK);
    SBAR(); qkt<DQK>(pB0, pB1, (bf16*)((char*)K_lds + SHM_K), qr, r32, hi, kcol);
    finishSM(pA0, pA1, l_reg, pa0, pa1, pa2, pa3); SBAR();
    pv_d0_exp(o, vb0, pa0, pa1, pa2, pa3, pB0); SBAR();
    __syncthreads(); SWAIT(); SWRITE(0, SE);
    __syncthreads();
    SLOAD(SE, (j + 2) * KVBLK);
    SBAR(); qkt<DQK>(pA0, pA1, K_lds, qr, r32, hi, kcol);
    finishSM(pB0, pB1, l_reg, pa0, pa1, pa2, pa3); SBAR();
    pv_d0_exp(o, vb0 + (int)SHM_V, pa0, pa1, pa2, pa3, pA0); SBAR();
    __syncthreads(); SWAIT(); SWRITE(1, SO);
    __syncthreads();
  }
  SBAR(); qkt<DQK>(pB0, pB1, (bf16*)((char*)K_lds + SHM_K), qr, r32, hi, kcol);
  finishSM(pA0, pA1, l_reg, pa0, pa1, pa2, pa3); SBAR();
  pv_d0_exp(o, vb0, pa0, pa1, pa2, pa3, pB0); SBAR();
  __syncthreads();
  finishSM(pB0, pB1, l_reg, pa0, pa1, pa2, pa3); SBAR();
  pv_d0(o, vb0 + (int)SHM_V, pa0, pa1, pa2, pa3);
  __builtin_amdgcn_s_setprio(0);
  { auto rr = __builtin_amdgcn_permlane32_swap(__float_as_uint(l_reg), __float_as_uint(l_reg), false, false); l_reg = __uint_as_float(rr[0]) + __uint_as_float(rr[1]); }
  if (hi == 0) li_l[r32] = l_reg; asm volatile("s_waitcnt lgkmcnt(0)" ::: "memory");
  float rli[16];
#pragma unroll
  for (int r = 0; r < 16; ++r) rli[r] = __builtin_amdgcn_rcpf(li_l[crow(r, hi)]);
  if constexpr (OF32) {
    float* Ow = (float*)Ob + (long)(wid * QBLK) * ldo;
#pragma unroll
    for (int r = 0; r < 16; ++r) { int orow = crow(r, hi);
      for (int d0 = 0; d0 < 4; ++d0) Ow[(long)orow * ldo + d0 * 32 + r32] = o[d0][r] * rli[r]; }
  } else {
    bf16* Ow = (bf16*)Ob + (long)(wid * QBLK) * ldo;
#pragma unroll
    for (int r = 0; r < 16; ++r) { int orow = crow(r, hi);
      for (int d0 = 0; d0 < 4; ++d0) Ow[(long)orow * ldo + d0 * 32 + r32] = __float2bfloat16(o[d0][r] * rli[r]); }
  }
  __syncthreads();
#undef SLOAD
#undef SWRITE
#undef SWAIT
}
#undef KSWZ
#undef SBAR
}
#ifndef REP_P0
#define REP_P0 1
#endif
#ifndef REP_K0
#define REP_K0 1
#endif
#ifndef REP_K2
#define REP_K2 1
#endif
#ifndef REP_K4
#define REP_K4 1
#endif
#ifndef REP_K5
#define REP_K5 1
#endif
#ifndef WIDE_MAX
#define WIDE_MAX 128
#endif
#ifndef REP_K7
#define REP_K7 1
#endif
#ifndef REP_K8
#define REP_K8 1
#endif
constexpr int NWAVES = 8, NTHREADS = 512;
constexpr int DM = 2048, NLAT = 8192, NCTX = 256, MR = NLAT + NCTX, DFF = 7168, NEXP = 8;
constexpr int PC = 3072;
constexpr int PC_QA = 0, PC_QB = 1024, PC_KA = 1536, PC_VA = 1792, PC_KB = 2048, PC_VB = 2560;
constexpr int WIN_ROWS = 4096;
constexpr int MOE_ROWS = 2 * NLAT + NEXP * 256;
constexpr float EPS = 1e-6f;
constexpr size_t MiB = 1u << 20;
constexpr size_t WS_CTL = 0, CTL_ZERO_BYTES = 1 * MiB;
constexpr size_t WS_MOD = 1 * MiB;
constexpr size_t WS_BF = WS_MOD + 256 * 1024;
constexpr size_t WS_TOK = 3 * MiB;
constexpr size_t WS_WGCNT = WS_TOK + 512 * 1024;
constexpr size_t WS_DFTC = 4 * MiB;
constexpr size_t WS_ZWTC = WS_DFTC + 512 * 1024;
constexpr size_t WS_WIN = 8 * MiB;
constexpr size_t WS_WOUT = 40 * MiB;
constexpr size_t WS_WGU = 56 * MiB;
constexpr size_t WS_WDN = 112 * MiB;
constexpr size_t WS_MGU = 140 * MiB;
constexpr size_t WS_MDN = 588 * MiB;
constexpr size_t WS_DFT = 812 * MiB;
constexpr size_t WS_X = 1068 * MiB;
constexpr size_t WS_H = 1134 * MiB;
constexpr size_t WS_O = 1167 * MiB;
constexpr size_t WS_P = 1200 * MiB;
constexpr size_t WS_ZWT = 1250 * MiB;
constexpr size_t WS_DIFFO = 1266 * MiB;
constexpr size_t WS_FP = 1299 * MiB;
constexpr size_t WS_Y = 1363 * MiB;
constexpr size_t WS_ACT = 1200 * MiB;
constexpr size_t WS_HS = 1200 * MiB;
constexpr size_t WS_DOUT = 1272 * MiB;
constexpr size_t WS_MACT = WS_DFT;
constexpr size_t WS_PART = 1344 * MiB;
constexpr size_t WS_END = 1412 * MiB;
constexpr int CW_TMO = 0, CW_BAR = 4096, CW_KMX = 8192, CW_TAIL = 9216;

constexpr int RING_BYTES = 131072, LDSCTL_OFF = RING_BYTES, MISC_OFF = LDSCTL_OFF + 12288, LDS_BYTES = 147456;

#define GAS __attribute__((address_space(1)))
#define LAS __attribute__((address_space(3)))
typedef unsigned short bf16_t;
typedef float f32x4 __attribute__((ext_vector_type(4)));
typedef unsigned u32x2 __attribute__((ext_vector_type(2)));
typedef unsigned u32x4 __attribute__((ext_vector_type(4)));

#define XB_TMO      128
#define XB_XCNT(j)  (256  + 64 * (j))
#define XB_XSUB(j)  (1280 + 64 * (j))
#define XB_XGEN(j)  (2304 + 64 * (j))
#define XB_TOP      3328
#define XB_TOPGEN   3392
#define XCD_BAR_WORDS 3456
#define XB_SPIN_CAP (1u << 18)
__device__ __forceinline__ unsigned xb_ld(unsigned* p)              { return __hip_atomic_load(p, __ATOMIC_RELAXED, __HIP_MEMORY_SCOPE_AGENT); }
__device__ __forceinline__ unsigned xb_add(unsigned* p, unsigned v) { return __hip_atomic_fetch_add(p, v, __ATOMIC_RELAXED, __HIP_MEMORY_SCOPE_AGENT); }
__device__ __forceinline__ unsigned xb_xcc_id() { return (unsigned)__builtin_amdgcn_s_getreg((3 << 11) | 20) & 0xFu; }
#define XB_SPIN(cond, bar) do { unsigned _sp = 0; while (cond) { __builtin_amdgcn_s_sleep(1); \
    if ((++_sp & 255u) == 0u) { if (xb_ld(&(bar)[XB_TMO])) break; if (_sp > XB_SPIN_CAP) { atomicAdd(&(bar)[XB_TMO], 1u); break; } } } } while (0)
struct XcdBarrier { unsigned* bar; unsigned x; volatile LAS unsigned* st; };
__device__ __forceinline__ XcdBarrier xcd_barrier_post(unsigned* bar, volatile LAS unsigned* st) {
    XcdBarrier b; b.bar = bar; b.x = xb_xcc_id(); b.st = st;
    if (threadIdx.x == 0) (void)xb_add(&bar[XB_XCNT(b.x)], 1u);
    return b;
}
__device__ __forceinline__ void xcd_barrier_complete(unsigned* bar, unsigned x, unsigned& nloc, unsigned& nx) {
    const unsigned G = gridDim.x * gridDim.y * gridDim.z;
    unsigned sum, cnt, mine, sp = 0u;
    for (;;) {
        sum = 0u; cnt = 0u; mine = 0u;
#pragma unroll
        for (unsigned j = 0; j < 16; ++j) { const unsigned c = xb_ld(&bar[XB_XCNT(j)]); sum += c; cnt += (c > 0u) ? 1u : 0u; mine = (j == x) ? c : mine; }
        if (sum == G) break;
        __builtin_amdgcn_s_sleep(1);
        if ((++sp & 255u) == 0u) { if (xb_ld(&bar[XB_TMO])) break; if (sp > XB_SPIN_CAP) { atomicAdd(&bar[XB_TMO], 1u); break; } }
    }
    nloc = mine > 0u ? mine : 1u; nx = cnt > 0u ? cnt : 1u;
}
__device__ __forceinline__ void xcd_barrier(const XcdBarrier& b) {
    asm volatile("s_waitcnt vmcnt(0)" ::: "memory");
    __syncthreads();
    if (threadIdx.x == 0) {
        unsigned* bar = b.bar; asm volatile("" : "+s"(bar));
        __builtin_amdgcn_s_waitcnt(0);
        unsigned nloc = b.st[0], nx = b.st[1];
        if (nloc == 0u) { xcd_barrier_complete(bar, b.x, nloc, nx); b.st[0] = nloc; b.st[1] = nx; }
        const unsigned old = xb_add(&bar[XB_XSUB(b.x)], 1u);
        const unsigned gen = old / nloc;
        if (old + 1u == (gen + 1u) * nloc) {
            __builtin_amdgcn_fence(__ATOMIC_RELEASE, "agent");
            asm volatile("s_waitcnt vmcnt(0)" ::: "memory");
            const unsigned og = xb_add(&bar[XB_TOP], 1u);
            const unsigned tg = og / nx;
            if (og + 1u == (tg + 1u) * nx) xb_add(&bar[XB_TOPGEN], 1u);
            else XB_SPIN(xb_ld(&bar[XB_TOPGEN]) == tg, bar);
            __builtin_amdgcn_fence(__ATOMIC_ACQUIRE, "agent");
            xb_add(&bar[XB_XGEN(b.x)], 1u);
            asm volatile("s_waitcnt vmcnt(0)" ::: "memory");
        } else {
            XB_SPIN(xb_ld(&bar[XB_XGEN(b.x)]) == gen, bar);
            __builtin_amdgcn_fence(__ATOMIC_ACQUIRE, "agent");
            asm volatile("s_waitcnt vmcnt(0)" ::: "memory");
        }
    }
    __syncthreads();
}

#define LDS_WAIT() asm volatile("s_waitcnt lgkmcnt(0)" ::: "memory")
__device__ __forceinline__ float wave_sum(float v) {
#pragma unroll
    for (int o = 1; o < 64; o <<= 1) v += __shfl_xor(v, o);
    return v;
}
__device__ __forceinline__ unsigned pk2(float lo, float hi) { return pg8::cvt_pk_bf16(lo, hi); }
__device__ __forceinline__ float bf_lo(unsigned u) { return __uint_as_float(u << 16); }
__device__ __forceinline__ float bf_hi(unsigned u) { return __uint_as_float(u & 0xffff0000u); }
__device__ __forceinline__ float silu_f(float v) { return v / (1.0f + __expf(-v)); }
__device__ __forceinline__ void ld_row_f32(const float* p, int lane, f32x4 (&v)[8]) {
    const f32x4* q = (const f32x4*)p + lane;
#pragma unroll
    for (int j = 0; j < 8; ++j) v[j] = q[64 * j];
}
__device__ __forceinline__ void ld_row_bf16(const bf16_t* p, int lane, f32x4 (&v)[8]) {
    const u32x2* q = (const u32x2*)p + lane;
#pragma unroll
    for (int j = 0; j < 8; ++j) { const u32x2 w = q[64 * j]; v[j] = (f32x4){bf_lo(w.x), bf_hi(w.x), bf_lo(w.y), bf_hi(w.y)}; }
}
__device__ __forceinline__ void st_row_bf16(bf16_t* p, int lane, const f32x4 (&v)[8]) {
    u32x2* q = (u32x2*)p + lane;
#pragma unroll
    for (int j = 0; j < 8; ++j) { u32x2 w; w.x = pk2(v[j].x, v[j].y); w.y = pk2(v[j].z, v[j].w); q[64 * j] = w; }
}
__device__ __forceinline__ void st_row_f32(float* p, int lane, const f32x4 (&v)[8]) {
    f32x4* q = (f32x4*)p + lane;
#pragma unroll
    for (int j = 0; j < 8; ++j) q[64 * j] = v[j];
}
__device__ __forceinline__ void ld_row_f32_nt(const float* p, int lane, f32x4 (&v)[8]) {
    const f32x4* q = (const f32x4*)p + lane;
#pragma unroll
    for (int j = 0; j < 8; ++j) v[j] = __builtin_nontemporal_load(q + 64 * j);
}
__device__ __forceinline__ void st_row_f32_nt(float* p, int lane, const f32x4 (&v)[8]) {
    f32x4* q = (f32x4*)p + lane;
#pragma unroll
    for (int j = 0; j < 8; ++j) __builtin_nontemporal_store(v[j], q + 64 * j);
}
__device__ __forceinline__ float row_sumsq(const f32x4 (&v)[8]) {
    float s = 0.f;
#pragma unroll
    for (int j = 0; j < 8; ++j) s += (v[j].x * v[j].x + v[j].y * v[j].y) + (v[j].z * v[j].z + v[j].w * v[j].w);
    return wave_sum(s);
}

__device__ __forceinline__ void transpose_item(const float* __restrict__ src, size_t ld, int k0, int c0, bf16_t* __restrict__ dst, size_t ldd, int r0, LAS float* scr, int lane) {
    const int lr = lane >> 3, lc = (lane & 7) * 4;
    f32x4 t[8];
#pragma unroll
    for (int i = 0; i < 8; ++i) t[i] = __builtin_nontemporal_load((const f32x4*)(src + (size_t)(k0 + 8 * i + lr) * ld + c0 + lc));
#pragma unroll
    for (int i = 0; i < 8; ++i) { LAS float* s = scr + (8 * i + lr) * 33 + lc; s[0] = t[i].x; s[1] = t[i].y; s[2] = t[i].z; s[3] = t[i].w; }
    LDS_WAIT(); asm volatile("" ::: "memory");
    const int c = lane & 7;
#pragma unroll
    for (int j = 0; j < 4; ++j) { const int n = (lane >> 3) + 8 * j; const LAS float* s = scr + (8 * c) * 33 + n;
        u32x4 o; o.x = pk2(s[0 * 33], s[1 * 33]); o.y = pk2(s[2 * 33], s[3 * 33]); o.z = pk2(s[4 * 33], s[5 * 33]); o.w = pk2(s[6 * 33], s[7 * 33]);
        __builtin_nontemporal_store(o, (u32x4*)(dst + (size_t)(r0 + n) * ldd + k0 + 8 * c)); }
    LDS_WAIT(); asm volatile("" ::: "memory");
}
__device__ __forceinline__ void transpose_item64(const float* __restrict__ src, size_t ld, int k0, int c0, bf16_t* __restrict__ dst, size_t ldd, int r0, LAS float* scr, int lane) {
    const int lr = lane >> 4, lc = (lane & 15) * 4;
    f32x4 t[16];
#pragma unroll
    for (int i = 0; i < 16; ++i) t[i] = __builtin_nontemporal_load((const f32x4*)(src + (size_t)(k0 + 4 * i + lr) * ld + c0 + lc));
#pragma unroll
    for (int i = 0; i < 16; ++i) { LAS float* s = scr + (4 * i + lr) * 65 + lc; s[0] = t[i].x; s[1] = t[i].y; s[2] = t[i].z; s[3] = t[i].w; }
    LDS_WAIT(); asm volatile("" ::: "memory");
    const int c = lane & 7;
#pragma unroll
    for (int j = 0; j < 8; ++j) { const int n = (lane >> 3) + 8 * j; const LAS float* s = scr + (8 * c) * 65 + n;
        u32x4 o; o.x = pk2(s[0 * 65], s[1 * 65]); o.y = pk2(s[2 * 65], s[3 * 65]); o.z = pk2(s[4 * 65], s[5 * 65]); o.w = pk2(s[6 * 65], s[7 * 65]);
        __builtin_nontemporal_store(o, (u32x4*)(dst + (size_t)(r0 + n) * ldd + k0 + 8 * c)); }
    LDS_WAIT(); asm volatile("" ::: "memory");
}
struct Args { const float* in[27]; float* out; unsigned char* ws; int ph_lo, ph_hi; };
__device__ __forceinline__ const float* inptr(const Args& a, int k) { asm volatile("" : "+s"(k)); return a.in[k]; }
__device__ __forceinline__ unsigned char* wsptr(const Args& a, size_t off) { unsigned char* p = a.ws; asm volatile("" : "+s"(p)); return p + off; }

__device__ __forceinline__ const float* modp(const unsigned char* ws, int l, int v, int chunk) { return (const float*)(ws + WS_MOD) + ((size_t)(l * 2 + v) * 6 + chunk) * DM; }

__device__ __forceinline__ void moe_tables(const unsigned char* ws, LAS unsigned char* ldsctl, LAS unsigned char* tmp, bool want_base, int G) {
    LAS int* T = (LAS int*)ldsctl; LAS int* W = (LAS int*)tmp;
    const int* wg = (const int*)(ws + WS_WGCNT);
    int tid = threadIdx.x; asm volatile("" : "+v"(tid));
    __syncthreads();
    for (int i = tid; i < G * 8; i += NTHREADS) W[i] = wg[i];
    __syncthreads();
    if (tid < 8) { int s = 0; for (int w = 0; w < G; ++w) s += W[w * 8 + tid]; T[16 + tid] = s; }
    __syncthreads();
    if (tid == 0) { int o = 0; for (int e = 0; e < 8; ++e) { T[e] = o; o += ((T[16 + e] + 255) >> 8) << 8; } T[8] = o; T[32] = o >> 8; }
    __syncthreads();
    if (tid < 72) { const int r = tid * 256; int e = 0;
#pragma unroll
        for (int j = 1; j < 8; ++j) e += (T[j] <= r) ? 1 : 0;
        T[64 + tid] = e; }
    if (want_base && tid < 8) { int s = T[tid]; for (int w = 0; w < G; ++w) { T[256 + w * 8 + tid] = s; s += W[w * 8 + tid]; } }
    __syncthreads();
}

constexpr int J_GU = 32 * 448, J_DN = 112 * 64, J_FFN = J_GU + J_DN;
__device__ __forceinline__ void ffn_weight_item(int e, int r, const float* w_gate_d, const float* w_up_d, const float* w_down_d, const float* w_gate_m, const float* w_up_m, const float* w_down_m,
                                                bf16_t* WGU, bf16_t* WDN, bf16_t* MGU, bf16_t* MDN, LAS float* scr, int lane) {
    if (r < J_GU) { const int kb = r / 448, nb = r % 448; const int n0 = nb * 32; const int tile = n0 >> 8, half = (n0 >> 7) & 1, j0 = n0 & 127;
        const float* src = e == 0 ? (half ? w_up_d : w_gate_d) : (half ? w_up_m : w_gate_m) + (size_t)(e - 1) * DM * DFF;
        bf16_t* dst = e == 0 ? WGU : MGU + (size_t)(e - 1) * 2 * DFF * DM;
        transpose_item(src, DFF, kb * 64, tile * 128 + j0, dst, DM, n0, scr, lane); }
    else { r -= J_GU; const int kb = r / 64, nb = r % 64;
        const float* src = e == 0 ? w_down_d : w_down_m + (size_t)(e - 1) * DFF * DM;
        bf16_t* dst = e == 0 ? WDN : MDN + (size_t)(e - 1) * DM * DFF;
        transpose_item(src, DM, kb * 64, nb * 32, dst, DFF, nb * 32, scr, lane); }
}

__global__ void __launch_bounds__(NTHREADS, 2) fwd_kernel(Args args) {
    extern __shared__ __attribute__((aligned(16))) unsigned char lds[];
    LAS unsigned char* L = (LAS unsigned char*)lds;
    volatile LAS unsigned* MISC = (volatile LAS unsigned*)(L + MISC_OFF);
    const int tid0 = threadIdx.x;
    const int G = gridDim.x, bx = blockIdx.x;
    const int vcu = (G % 8 == 0) ? (bx % 8) * (G / 8) + bx / 8 : bx;
    const int NGW = G * NWAVES;
#define PHASE_LOCALS int tid = tid0; asm volatile("" : "+v"(tid)); const int lane = tid & 63, wave = __builtin_amdgcn_readfirstlane(tid >> 6), gw = vcu * NWAVES + wave; (void)lane; (void)wave; (void)gw;
    unsigned char* ws = args.ws;
    unsigned* ctl = (unsigned*)(ws + WS_CTL);
    for (int u = tid0; u < (LDS_BYTES - LDSCTL_OFF) / 4; u += NTHREADS) ((LAS unsigned*)(L + LDSCTL_OFF))[u] = 0u;
    __syncthreads();
    XcdBarrier bar = xcd_barrier_post(ctl + CW_BAR, MISC + 8);
    const int lo = args.ph_lo, hi = args.ph_hi;
#define IN(k) (lo <= (k) && (k) < hi)
#define SEAM(k) do { if (IN(k) && IN((k) + 1)) xcd_barrier(bar); } while (0)

    const float* x_in = args.in[0]; const float* c_in = args.in[1]; const float* ctx_in = args.in[2]; const float* cctx_in = args.in[3];
    const float* w_mod = args.in[4]; const float* b_mod = args.in[5];
    const float* g_pre_mix = args.in[6]; const float* g_post_mix = args.in[7]; const float* g_pre_ffn = args.in[8]; const float* g_post_ffn = args.in[9];
    const float* w_in = args.in[10]; const float* g_q_a = args.in[11]; const float* g_k_a = args.in[12];
    const float* lq1 = args.in[13]; const float* lk1 = args.in[14]; const float* lq2 = args.in[15]; const float* lk2 = args.in[16];
    const float* g_subln = args.in[17]; const float* w_fourier = args.in[18]; const float* w_out = args.in[19];
    const float* w_gate_d = args.in[20]; const float* w_up_d = args.in[21]; const float* w_down_d = args.in[22]; const float* w_router = args.in[23];
    const float* w_gate_m = args.in[24]; const float* w_up_m = args.in[25]; const float* w_down_m = args.in[26];
    bf16_t* WIN = (bf16_t*)(ws + WS_WIN); bf16_t* WOUT = (bf16_t*)(ws + WS_WOUT); bf16_t* WGU = (bf16_t*)(ws + WS_WGU); bf16_t* WDN = (bf16_t*)(ws + WS_WDN);
    bf16_t* MGU = (bf16_t*)(ws + WS_MGU); bf16_t* MDN = (bf16_t*)(ws + WS_MDN); bf16_t* DFT = (bf16_t*)(ws + WS_DFT); bf16_t* DFTC = (bf16_t*)(ws + WS_DFTC);
    float* X = (float*)(ws + WS_X); bf16_t* H = (bf16_t*)(ws + WS_H); bf16_t* O = (bf16_t*)(ws + WS_O); bf16_t* P = (bf16_t*)(ws + WS_P);
    bf16_t* ZWT = (bf16_t*)(ws + WS_ZWT); bf16_t* ZWTC = (bf16_t*)(ws + WS_ZWTC); bf16_t* DIFFO = (bf16_t*)(ws + WS_DIFFO); bf16_t* Y1 = (bf16_t*)(ws + WS_FP);
    bf16_t* Y = (bf16_t*)(ws + WS_Y); bf16_t* ACT = (bf16_t*)(ws + WS_ACT); bf16_t* HS = (bf16_t*)(ws + WS_HS); bf16_t* DOUT = (bf16_t*)(ws + WS_DOUT); bf16_t* MACT = (bf16_t*)(ws + WS_MACT);
    float* BF = (float*)(ws + WS_BF); unsigned* TOK = (unsigned*)(ws + WS_TOK); int* WGCNT = (int*)(ws + WS_WGCNT);

    if (IN(0)) for (int rep_ = 0; rep_ < REP_P0; ++rep_) {
        PHASE_LOCALS
        {
            LAS float* sl = (LAS float*)L; LAS float* scx = sl + DM; LAS float* red = scx + DM;
            __syncthreads();
            for (int k = tid; k < DM; k += NTHREADS) { sl[k] = silu_f(c_in[k]); scx[k] = silu_f(cctx_in[k]); }
            __syncthreads();
            for (int job = vcu; job < 256; job += G) {
                const int l = job >> 7, cg = job & 127;
                const float* wm = w_mod + (size_t)l * DM * 12288 + cg * 96;
                const int c4 = tid % 24, rg = tid / 24;
                f32x4 al = {0.f, 0.f, 0.f, 0.f}, ac = {0.f, 0.f, 0.f, 0.f};
                if (rg < 21) {
#pragma unroll 14
                    for (int k = rg; k < DM; k += 21) { const f32x4 w = __builtin_nontemporal_load((const f32x4*)(wm + (size_t)k * 12288 + c4 * 4));     const float a = sl[k], b = scx[k]; al += w * a; ac += w * b; }
                    LAS float* r = red + (rg * 24 + c4) * 8; r[0] = al.x; r[1] = al.y; r[2] = al.z; r[3] = al.w; r[4] = ac.x; r[5] = ac.y; r[6] = ac.z; r[7] = ac.w;
                }
                __syncthreads();
                if (tid < 192) { const int v = tid / 96, col = tid % 96; float s = 0.f; for (int r = 0; r < 21; ++r) s += red[(r * 24 + (col >> 2)) * 8 + v * 4 + (col & 3)];
                    ((float*)(ws + WS_MOD))[(size_t)(l * 2 + v) * 12288 + cg * 96 + col] = s + b_mod[(size_t)l * 12288 + cg * 96 + col]; }
                __syncthreads();
            }
        }
        for (int job = vcu; job < 16; job += G) {
            const int l = job >> 3, part = (job >> 2) & 1, g = job & 3;
            LAS float* Wl = (LAS float*)L; LAS float* tb = Wl + 128 * 128;
            const float* W = w_fourier + (size_t)(l * 4 + g) * 128 * 128;
            for (int i = tid; i < 128 * 128; i += NTHREADS) Wl[i] = W[i];
            if (tid < 128) { const float ph = (float)tid * (1.0f / 128.0f); tb[tid] = (part ? -__builtin_amdgcn_sinf(ph) : __builtin_amdgcn_cosf(ph)) * 0.08838834764831845f; }
            __syncthreads();
            const int d4 = tid & 31, cg = tid >> 5;
            f32x4 acc[8];
#pragma unroll
            for (int i = 0; i < 8; ++i) acc[i] = (f32x4){0.f, 0.f, 0.f, 0.f};
#pragma unroll 2
            for (int lp = 0; lp < 128; ++lp) { const f32x4 wv = *(const LAS f32x4*)(Wl + lp * 128 + 4 * d4);
#pragma unroll
                for (int i = 0; i < 8; ++i) acc[i] += wv * tb[(lp * (cg * 8 + i)) & 127]; }
            float* out = BF + ((size_t)((l * 2 + part) * 4 + g) * 128) * 128;
#pragma unroll
            for (int i = 0; i < 8; ++i) *(f32x4*)(out + (size_t)(cg * 8 + i) * 128 + 4 * d4) = acc[i];
            __syncthreads();
        }
        {
            const int gt = vcu * NTHREADS + tid, NT = G * NTHREADS;
            for (int i = gt; i < 1024 * 128; i += NT) { const int m = i >> 7, c8 = (i & 127) * 8; const int ro = m >> 9, k1 = m & 511, part = c8 >> 9, n1 = c8 & 511;
                float v[8];
#pragma unroll
                for (int j = 0; j < 8; ++j) { const float ph = (float)((k1 * (n1 + j)) & 511) * (1.0f / 512.0f); const float cs = __builtin_amdgcn_cosf(ph), sn = __builtin_amdgcn_sinf(ph);
                    v[j] = (ro == 0 ? (part == 0 ? cs : sn) : (part == 0 ? -sn : cs)) * 0.011048543456039806f; }
                u32x4 o; o.x = pk2(v[0], v[1]); o.y = pk2(v[2], v[3]); o.z = pk2(v[4], v[5]); o.w = pk2(v[6], v[7]);
                *(u32x4*)(DFT + (size_t)i * 8) = o; }
            for (int i = gt; i < NCTX * 64; i += NT) { const int k = i >> 6, n8 = (i & 63) * 8; const int part = n8 >= NCTX; const int n = n8 & (NCTX - 1);
                float v[8];
#pragma unroll
                for (int j = 0; j < 8; ++j) { const float ph = (float)((k * (n + j)) & (NCTX - 1)) * (1.0f / NCTX); v[j] = (part ? __builtin_amdgcn_sinf(ph) : __builtin_amdgcn_cosf(ph)) * 0.0625f; }
                u32x4 o; o.x = pk2(v[0], v[1]); o.y = pk2(v[2], v[3]); o.z = pk2(v[4], v[5]); o.w = pk2(v[6], v[7]);
                *(u32x4*)(DFTC + (size_t)i * 8) = o; }
        }
        {
            LAS float* scr = (LAS float*)(L + wave * 16640);
            constexpr int I_IN = 32 * 96, I_OUT = 32 * 64;
            constexpr int NITEMS = 2 * I_IN + 2 * I_OUT;
            for (int it = gw; it < NITEMS; it += NGW) {
                int r = it;
                if (r < 2 * I_IN) { const int l = r / I_IN; r %= I_IN; const int kb = r / 96, nb = r % 96; const int n0 = nb * 32; const int c0 = n0 < 1536 ? n0 : n0 + 512;
                    transpose_item(w_in + (size_t)l * DM * 3584, 3584, kb * 64, c0, WIN + (size_t)l * WIN_ROWS * DM, DM, n0, scr, lane); continue; }
                r -= 2 * I_IN;
                { const int l = r / I_OUT; r %= I_OUT; const int kb = r / 64, nb = r % 64;
                    transpose_item(w_out + (size_t)l * DM * DM, DM, kb * 64, nb * 32, WOUT + (size_t)l * DM * DM, DM, nb * 32, scr, lane); }
            }
            { LAS float* scr64 = (LAS float*)(L + wave * 16640); const int npro = (G % 2 == 0) ? 1 : 9;
              for (int it = gw; it < npro * J_FFN; it += NGW) ffn_weight_item(it / J_FFN, it % J_FFN, w_gate_d, w_up_d, w_down_d, w_gate_m, w_up_m, w_down_m, WGU, WDN, MGU, MDN, scr64, lane); }
        }
    }
    SEAM(0);

    if (IN(1)) {
        PHASE_LOCALS
        for (int job = vcu; job < 512; job += G) {
            const int l = job >> 8, g = (job >> 6) & 3, part = (job >> 5) & 1, kb = job & 31;
            LAS float* Wc = (LAS float*)L; LAS float* Bp = Wc + 64 * 128;
            __syncthreads();
            for (int i = tid; i < 64 * 32; i += NTHREADS) { const int row = i >> 5, c4 = (i & 31) * 4; *(LAS f32x4*)(Wc + row * 128 + c4) = *(const f32x4*)(w_in + ((size_t)l * DM + kb * 64 + row) * 3584 + 1536 + g * 128 + c4); }
            const float* bsrc = BF + ((size_t)((l * 2 + part) * 4 + g) * 128) * 128;
            for (int i = tid; i < 128 * 32; i += NTHREADS) *(LAS f32x4*)(Bp + i * 4) = *(const f32x4*)(bsrc + i * 4);
            __syncthreads();
            const int d4 = tid & 31, kg = tid >> 5;
            f32x4 acc[4];
#pragma unroll
            for (int i = 0; i < 4; ++i) acc[i] = (f32x4){0.f, 0.f, 0.f, 0.f};
#pragma unroll 4
            for (int c = 0; c < 128; ++c) { const f32x4 bv = *(const LAS f32x4*)(Bp + c * 128 + 4 * d4);
#pragma unroll
                for (int i = 0; i < 4; ++i) acc[i] += bv * Wc[(4 * kg + i) * 128 + c]; }
#pragma unroll
            for (int e = 0; e < 4; ++e) { u32x2 o; o.x = pk2(acc[0][e], acc[1][e]); o.y = pk2(acc[2][e], acc[3][e]);
                *(u32x2*)(WIN + (size_t)l * WIN_ROWS * DM + (size_t)(3072 + part * 512 + g * 128 + 4 * d4 + e) * DM + kb * 64 + 4 * kg) = o; }
        }
        __syncthreads();
        LAS float* va = (LAS float*)L;
        for (int i = tid; i < 2 * DM; i += NTHREADS) { const int v = i >> 11, c = i & (DM - 1); va[(v * 2 + 0) * DM + c] = g_pre_mix[c] * (1.0f + modp(ws, 0, v, 1)[c]); va[(v * 2 + 1) * DM + c] = modp(ws, 0, v, 0)[c]; }
        __syncthreads();
        for (int row = gw; row < MR; row += NGW) {
            const int v = row >= NLAT; const float* src = v ? ctx_in + (size_t)(row - NLAT) * DM : x_in + (size_t)row * DM;
            f32x4 xv[8]; ld_row_f32_nt(src, lane, xv);
            const float r = __builtin_amdgcn_rsqf(row_sumsq(xv) * (1.0f / DM) + EPS);
            const LAS f32x4* A = (const LAS f32x4*)(va + (v * 2) * DM) + lane; const LAS f32x4* B = (const LAS f32x4*)(va + (v * 2 + 1) * DM) + lane;
#pragma unroll
            for (int j = 0; j < 8; ++j) xv[j] = xv[j] * r * A[64 * j] + B[64 * j];
            st_row_bf16(H + (size_t)row * DM, lane, xv);
        }
    }
    SEAM(1);
    for (int l = 0; l < 2; ++l) {
        const int PB = 2 + l * 10;
        bf16_t* WINl = WIN + (size_t)l * WIN_ROWS * DM; bf16_t* WOUTl = WOUT + (size_t)l * DM * DM;
        const int nrows = l == 0 ? MR : NLAT;
        const float lambda_init = l == 0 ? 0.2f : 0.35550906759096927f;

        if (IN(PB + 0)) for (int rep_ = 0; rep_ < REP_K0; ++rep_) {
#ifndef NO_G0
            { pg8::Gemm g{H, WINl, DM, DM, DM}; pg8::SchedIn S{G, bx, 0, 0};
              pg8::EpiBf16 E{P, PC, P, PC};
              pg8::gemm_phase<pg8::EpiBf16, pg8::SchedIn, true>(L, g, S, E); }
#endif
#ifndef NO_G1
            { pg8::Gemm g{WINl + (size_t)3072 * DM, H, DM, 16 * DM, DM}; pg8::SchedZW S{G, (bx + G / 2) % G};
              pg8::EpiBf16 E{ZWT, 16384, ZWTC, 512};
              pg8::gemm_phase<pg8::EpiBf16, pg8::SchedZW, true>(L, g, S, E); }
#endif
            { PHASE_LOCALS
              const bf16_t* Hc = H + (size_t)NLAT * DM; bf16_t* Pc = P + (size_t)NLAT * PC;
              if (l == 0) {
                            pg8::ctx_gemm<0>(Hc, DM, WINl, DM, DM, 48, 0, Pc, PC, 0, L, tid, vcu, G);
                            pg8::ctx_gemm<2>(Hc, DM, WINl, DM, DM, 16, 3072, ZWTC, 512, 0, L, tid, (vcu + 64) % G, G);
              } else {
                            pg8::ctx_gemm<0>(Hc, DM, WINl, DM, DM, 24, 1536, Pc, PC, 1536, L, tid, vcu, G);
              }
            }
        }
        SEAM(PB + 0);

        if (IN(PB + 1)) {
            PHASE_LOCALS
            const int sub = lane >> 3, t = lane & 7;
            for (int row = gw; row < MR; row += NGW) {
                const bool is_lat = row < NLAT; const int prow = row >> 6, pcol = row & 63;
                bf16_t* pr = P + (size_t)row * PC;
#pragma unroll 1
                for (int pass = 0; pass < 3; ++pass) {
                    const int seg = pass * 8 + sub;
                    if (seg >= 18) continue;
                    if (l == 1 && !is_lat && seg < 12) continue;
                    const bool typeA = seg < 8 || (seg >= 12 && seg < 14), isq = seg < 12;
                    const int col0 = seg < 8 ? PC_QA + seg * 128 : seg < 12 ? PC_QB + (seg - 8) * 128 : seg < 14 ? PC_KA + (seg - 12) * 128 : PC_KB + (seg - 14) * 128;
                    int cA_, cB_, jb; bool is_col; float fmul;
                    if (typeA) { cA_ = t < 4 ? t : t + 4; cB_ = cA_ + 4; jb = (t & 3) * 8; is_col = t >= 4; fmul = -0.41524101186092029f; }
                    else { const int v = t >> 2, tt = t & 3; const int cc = tt < 2 ? tt : tt + 2; cA_ = v * 8 + cc; cB_ = cA_ + 2; jb = (tt & 1) * 8; is_col = tt >= 2; fmul = -0.83048202372184059f; }
                    u32x4 wa = *(const u32x4*)(pr + col0 + cA_ * 8), wb = *(const u32x4*)(pr + col0 + cB_ * 8);
                    float xa[8], xb[8];
                    xa[0] = bf_lo(wa.x); xa[1] = bf_hi(wa.x); xa[2] = bf_lo(wa.y); xa[3] = bf_hi(wa.y); xa[4] = bf_lo(wa.z); xa[5] = bf_hi(wa.z); xa[6] = bf_lo(wa.w); xa[7] = bf_hi(wa.w);
                    xb[0] = bf_lo(wb.x); xb[1] = bf_hi(wb.x); xb[2] = bf_lo(wb.y); xb[3] = bf_hi(wb.y); xb[4] = bf_lo(wb.z); xb[5] = bf_hi(wb.z); xb[6] = bf_lo(wb.w); xb[7] = bf_hi(wb.w);
                    if (typeA) {
                        float ss = 0.f;
#pragma unroll
                        for (int i = 0; i < 8; ++i) ss += xa[i] * xa[i] + xb[i] * xb[i];
                        ss += __shfl_xor(ss, 1); ss += __shfl_xor(ss, 2); ss += __shfl_xor(ss, 4);
                        const float r = __builtin_amdgcn_rsqf(ss * (1.0f / 128.0f) + EPS);
                        const float* gv = (seg < 8 ? g_q_a : g_k_a) + l * 128;
#pragma unroll
                        for (int i = 0; i < 8; ++i) { xa[i] *= r * gv[cA_ * 8 + i]; xb[i] *= r * gv[cB_ * 8 + i]; }
                    }
                    if (is_lat) {
                        const float pos = (float)(is_col ? pcol : prow);
#pragma unroll
                        for (int i = 0; i < 8; ++i) { const float fr = __builtin_amdgcn_exp2f((float)(jb + i) * fmul); const float rev = pos * fr * 0.15915494309189535f;
                            const float cs = __builtin_amdgcn_cosf(rev), sn = __builtin_amdgcn_sinf(rev); const float a = xa[i], b = xb[i]; xa[i] = a * cs - b * sn; xb[i] = b * cs + a * sn; }
                    }
                    if (isq) { const float cq = typeA ? 0.12751743082459868f : 0.18033688011112042f;
#pragma unroll
                        for (int i = 0; i < 8; ++i) { xa[i] *= cq; xb[i] *= cq; } }
                    wa.x = pk2(xa[0], xa[1]); wa.y = pk2(xa[2], xa[3]); wa.z = pk2(xa[4], xa[5]); wa.w = pk2(xa[6], xa[7]);
                    wb.x = pk2(xb[0], xb[1]); wb.y = pk2(xb[2], xb[3]); wb.z = pk2(xb[4], xb[5]); wb.w = pk2(xb[6], xb[7]);
                    if (isq || typeA || is_lat) { *(u32x4*)(pr + col0 + cA_ * 8) = wa; *(u32x4*)(pr + col0 + cB_ * 8) = wb; }
                }
            }
        }
        SEAM(PB + 1);

        if (IN(PB + 2)) for (int rep_ = 0; rep_ < REP_K2; ++rep_) {
            PHASE_LOCALS
            const int nctxu = l == 0 ? 8 : 0;
#define MOE_CONVERT() do { if (G % 2 == 0) { LAS float* scr_ = (LAS float*)(L + wave * 16640); \
          \
        const int ib_ = (1 + 4 * l) * J_FFN, ie_ = (5 + 4 * l) * J_FFN; const bool skew_ = G == 256; const int nall_ = skew_ ? 37 : (4 * J_FFN + NGW - 1) / NGW, nown_ = nall_ + ((skew_ && bx < 128) ? 10 : 0); \
        for (int r_ = 0; r_ < nown_; ++r_) { const int it_ = ib_ + (r_ < nall_ ? r_ * NGW + gw : nall_ * NGW + (r_ - nall_) * (NGW / 2) + bx * NWAVES + wave); if (it_ >= ie_) break; \
            ffn_weight_item(it_ / J_FFN, it_ % J_FFN, w_gate_d, w_up_d, w_down_d, w_gate_m, w_up_m, w_down_m, WGU, WDN, MGU, MDN, scr_, lane); } \
        __syncthreads(); } } while (0)
            if (vcu % 3 == 0) MOE_CONVERT();
#ifndef NO_ATTA
            for (int U = vcu; U < 256 + nctxu; U += G) {
                const bool isc = U >= 256; const int head = isc ? U - 256 : U >> 5, qrow = isc ? NLAT : (U & 31) * 256, krow = isc ? NLAT : 0, seq = isc ? NCTX : MR;
                att::attn_unit<128, false, PC>((const att::bf16*)(P + (size_t)qrow * PC + PC_QA + head * 128), (const att::bf16*)(P + (size_t)krow * PC + PC_KA + (head >> 2) * 128),
                    (const att::bf16*)(P + (size_t)krow * PC + PC_VA + (head >> 2) * 128), (void*)(Y + (size_t)qrow * DM + head * 128), DM, seq, 0, (char*)lds);
            }
#endif
            if (vcu % 3 == 1) MOE_CONVERT();
#ifndef NO_ATTB
            for (int U = vcu; U < 256 + nctxu; U += G) {
                const bool isc = U >= 256; const int hc = isc ? U - 256 : U >> 5, head = hc >> 1, comp = hc & 1, qrow = isc ? NLAT : (U & 31) * 256, krow = isc ? NLAT : 0, seq = isc ? NCTX : MR;
                att::attn_unit<64, false, PC>((const att::bf16*)(P + (size_t)qrow * PC + PC_QB + head * 128 + comp * 64), (const att::bf16*)(P + (size_t)krow * PC + PC_KB + head * 128),
                    (const att::bf16*)(P + (size_t)krow * PC + PC_VB + head * 128), (void*)(DIFFO + (size_t)comp * MR * 512 + (size_t)qrow * 512 + head * 128), 512, seq, comp * 64, (char*)lds);
            }
#endif
            if (vcu % 3 == 2) MOE_CONVERT();
#undef MOE_CONVERT
#ifndef NO_GEMM
            { pg8::Gemm g{DFT, ZWT, 1024, 16384, 1024}; pg8::SchedF1 S{G, (bx + G / 2) % G};
              pg8::EpiBf16 E{Y1, 512, Y1, 512};
              pg8::gemm_phase<pg8::EpiBf16, pg8::SchedF1, true>(L, g, S, E); }
#endif
        }
        SEAM(PB + 2);

        if (IN(PB + 3)) {
            PHASE_LOCALS
            const float lam = __expf(wave_sum(lq1[l * 64 + lane] * lk1[l * 64 + lane])) - __expf(wave_sum(lq2[l * 64 + lane] * lk2[l * 64 + lane])) + lambda_init;
            const float g0 = g_subln[l * 128 + 2 * lane] * (1.0f - lambda_init), g1 = g_subln[l * 128 + 2 * lane + 1] * (1.0f - lambda_init);
            for (int row = gw; row < nrows; row += NGW) {
#pragma unroll
                for (int h = 0; h < 4; ++h) {
                    const unsigned u1_ = *(const unsigned*)(DIFFO + (size_t)row * 512 + h * 128 + 2 * lane), u2_ = *(const unsigned*)(DIFFO + (size_t)MR * 512 + (size_t)row * 512 + h * 128 + 2 * lane);
                    const float2 o1 = {bf_lo(u1_), bf_hi(u1_)}, o2 = {bf_lo(u2_), bf_hi(u2_)};
                    const float d0 = o1.x - lam * o2.x, d1 = o1.y - lam * o2.y;
                    const float r = __builtin_amdgcn_rsqf(wave_sum(d0 * d0 + d1 * d1) * (1.0f / 128.0f) + EPS);
                    *(unsigned*)(Y + (size_t)row * DM + 1024 + h * 128 + 2 * lane) = pk2(d0 * r * g0, d1 * r * g1);
                }
            }
            for (int item = gw; item < 2048; item += NGW) {
                const int k1 = item >> 2, qf = item & 3;
                f32x4 a0[4], a1[4];
#pragma unroll
                for (int j = 0; j < 4; ++j) { a0[j] = (f32x4){0.f, 0.f, 0.f, 0.f}; a1[j] = (f32x4){0.f, 0.f, 0.f, 0.f}; }
#pragma unroll 2
                for (int n2 = 0; n2 < 16; ++n2) {
                    const u32x4 wr_ = *(const u32x4*)(Y1 + ((size_t)n2 * 1024 + k1) * 512 + 8 * lane), wi_ = *(const u32x4*)(Y1 + ((size_t)n2 * 1024 + 512 + k1) * 512 + 8 * lane);
                    const f32x4 r0 = {bf_lo(wr_.x), bf_hi(wr_.x), bf_lo(wr_.y), bf_hi(wr_.y)}, r1 = {bf_lo(wr_.z), bf_hi(wr_.z), bf_lo(wr_.w), bf_hi(wr_.w)};
                    const f32x4 i0 = {bf_lo(wi_.x), bf_hi(wi_.x), bf_lo(wi_.y), bf_hi(wi_.y)}, i1 = {bf_lo(wi_.z), bf_hi(wi_.z), bf_lo(wi_.w), bf_hi(wi_.w)};
#pragma unroll
                    for (int j = 0; j < 4; ++j) { const int kk = k1 + 512 * (4 * qf + j); const float ph = (float)((n2 * kk) & 8191) * (1.0f / 8192.0f);
                        const float cs = __builtin_amdgcn_cosf(ph), sn = __builtin_amdgcn_sinf(ph);
                        a0[j] += r0 * cs + i0 * sn; a1[j] += r1 * cs + i1 * sn; }
                }
#pragma unroll
                for (int j = 0; j < 4; ++j) { const int kk = k1 + 512 * (4 * qf + j);
                    u32x4 w; w.x = pk2(a0[j].x, a0[j].y); w.y = pk2(a0[j].z, a0[j].w); w.z = pk2(a1[j].x, a1[j].y); w.w = pk2(a1[j].z, a1[j].w);
                    *(u32x4*)(Y + (size_t)kk * DM + 1536 + 8 * lane) = w; }
            }
            if (l == 0) {
                for (int idx = vcu * NTHREADS + tid; idx < NCTX * 512; idx += G * NTHREADS) {
                    const int k = idx >> 9, d = idx & 511; const u32x4* a = (const u32x4*)(DFTC + (size_t)k * 512); const u32x4* b = (const u32x4*)(ZWTC + (size_t)d * 512);
                    float s = 0.f;
#pragma unroll 16
                    for (int i = 0; i < 64; ++i) { const u32x4 wa = a[i], wb = b[i];
                        s += bf_lo(wa.x) * bf_lo(wb.x) + bf_hi(wa.x) * bf_hi(wb.x) + bf_lo(wa.y) * bf_lo(wb.y) + bf_hi(wa.y) * bf_hi(wb.y)
                           + bf_lo(wa.z) * bf_lo(wb.z) + bf_hi(wa.z) * bf_hi(wb.z) + bf_lo(wa.w) * bf_lo(wb.w) + bf_hi(wa.w) * bf_hi(wb.w); }
                    Y[(size_t)(NLAT + k) * DM + 1536 + d] = (bf16_t)(pk2(s, 0.f) & 0xffffu);
                }
            }
        }
        SEAM(PB + 3);

        if (IN(PB + 4)) for (int rep_ = 0; rep_ < REP_K4; ++rep_) {
            pg8::Gemm g{Y, WOUTl, DM, DM, DM}; pg8::SchedTiles S{32, 8, 256, G, bx, DM, DM, 256};
            pg8::EpiBf16 E{O, DM, O, DM};
#ifndef NO_G4
            pg8::gemm_phase<pg8::EpiBf16, pg8::SchedTiles, true>(L, g, S, E);
#endif
            if (l == 0) { PHASE_LOCALS
                pg8::ctx_gemm<0>(Y + (size_t)NLAT * DM, DM, WOUTl, DM, DM, 32, 0, O + (size_t)NLAT * DM, DM, 0, L, tid, vcu, G);
            }
        }
        SEAM(PB + 4);

        if (IN(PB + 5)) {
            PHASE_LOCALS
            LAS float* vv = (LAS float*)L;
            LAS float* wr = vv + 6 * DM;
            LAS int* lcnt = (LAS int*)(L + LDSCTL_OFF + 2048);
            __syncthreads();
            for (int i = tid; i < 2 * DM; i += NTHREADS) { const int v = i >> 11, c = i & (DM - 1);
                vv[(v * 3 + 0) * DM + c] = modp(ws, l, v, 2)[c] * g_post_mix[l * DM + c];
                vv[(v * 3 + 1) * DM + c] = g_pre_ffn[l * DM + c] * (1.0f + modp(ws, l, v, 4)[c]);
                vv[(v * 3 + 2) * DM + c] = modp(ws, l, v, 3)[c]; }
            if (l == 1) { for (int i = tid; i < DM * 8 / 4; i += NTHREADS) ((LAS f32x4*)wr)[i] = ((const f32x4*)w_router)[i]; if (tid < 8) lcnt[tid] = 0; }
            __syncthreads();
            for (int rep5_ = 0; rep5_ < (l == 0 ? REP_K5 : 1); ++rep5_)
            for (int row = gw; row < nrows; row += NGW) {
                const int v = row >= NLAT;
                const float* xs = l == 0 ? (v ? ctx_in + (size_t)(row - NLAT) * DM : x_in + (size_t)row * DM) : X + (size_t)row * DM;
                f32x4 ov[8], xv[8]; ld_row_bf16(O + (size_t)row * DM, lane, ov); ld_row_f32_nt(xs, lane, xv);
                const float r1 = __builtin_amdgcn_rsqf(row_sumsq(ov) * (1.0f / DM) + EPS);
                const LAS f32x4* GG = (const LAS f32x4*)(vv + (v * 3 + 0) * DM) + lane; const LAS f32x4* A2 = (const LAS f32x4*)(vv + (v * 3 + 1) * DM) + lane; const LAS f32x4* B2 = (const LAS f32x4*)(vv + (v * 3 + 2) * DM) + lane;
#pragma unroll
                for (int j = 0; j < 8; ++j) xv[j] = xv[j] + ov[j] * r1 * GG[64 * j];
                st_row_f32_nt(X + (size_t)row * DM, lane, xv);
                const float r2 = __builtin_amdgcn_rsqf(row_sumsq(xv) * (1.0f / DM) + EPS);
#pragma unroll
                for (int j = 0; j < 8; ++j) xv[j] = xv[j] * r2 * A2[64 * j] + B2[64 * j];
                st_row_bf16(H + (size_t)row * DM, lane, xv);
                if (l == 1) {
                    float lg[8];
#pragma unroll
                    for (int e = 0; e < 8; ++e) lg[e] = 0.f;
#pragma unroll
                    for (int j = 0; j < 8; ++j)
#pragma unroll
                        for (int i = 0; i < 4; ++i) { const int col = 4 * lane + 256 * j + i; const f32x4 w0 = *(const LAS f32x4*)(wr + col * 8), w1 = *(const LAS f32x4*)(wr + col * 8 + 4); const float hv = xv[j][i];
                            lg[0] += hv * w0.x; lg[1] += hv * w0.y; lg[2] += hv * w0.z; lg[3] += hv * w0.w; lg[4] += hv * w1.x; lg[5] += hv * w1.y; lg[6] += hv * w1.z; lg[7] += hv * w1.w; }
#pragma unroll
                    for (int e = 0; e < 8; ++e) lg[e] = wave_sum(lg[e]);
                    int i0 = 0; float m0 = lg[0];
#pragma unroll
                    for (int e = 1; e < 8; ++e) if (lg[e] > m0) { m0 = lg[e]; i0 = e; }
                    int i1 = -1; float m1 = -INFINITY;
#pragma unroll
                    for (int e = 0; e < 8; ++e) if (e != i0 && lg[e] > m1) { m1 = lg[e]; i1 = e; }
                    const float ex = __expf(m1 - m0); const float w0 = 1.0f / (1.0f + ex), w1 = ex / (1.0f + ex);
                    if (lane == 0) { const int r0 = __hip_atomic_fetch_add(&lcnt[i0], 1, __ATOMIC_RELAXED, __HIP_MEMORY_SCOPE_WORKGROUP), r1_ = __hip_atomic_fetch_add(&lcnt[i1], 1, __ATOMIC_RELAXED, __HIP_MEMORY_SCOPE_WORKGROUP);
                        u32x4 ta; ta.x = (unsigned)i0; ta.y = (unsigned)i1; ta.z = (unsigned)r0; ta.w = (unsigned)r1_; *(u32x4*)(TOK + (size_t)row * 8) = ta;
                        TOK[(size_t)row * 8 + 4] = __float_as_uint(w0); TOK[(size_t)row * 8 + 5] = __float_as_uint(w1); }
                }
            }
            if (l == 1) { __syncthreads(); if (tid < 8) WGCNT[vcu * 8 + tid] = lcnt[tid]; }
        }
        SEAM(PB + 5);

        if (l == 1) {
            if (IN(PB + 6)) {
                PHASE_LOCALS
                moe_tables(ws, L + LDSCTL_OFF, L, true, G);
                const LAS int* T = (const LAS int*)(L + LDSCTL_OFF);
                for (int row = gw; row < NLAT; row += NGW) {
                    const u32x4 ta = *(const u32x4*)(TOK + (size_t)row * 8);
                    const int p0 = T[256 + vcu * 8 + (int)ta.x] + (int)ta.z, p1 = T[256 + vcu * 8 + (int)ta.y] + (int)ta.w;
                    if (lane == 0) { TOK[(size_t)row * 8 + 6] = (unsigned)p0; TOK[(size_t)row * 8 + 7] = (unsigned)p1; }
                    const u32x4* src = (const u32x4*)(H + (size_t)row * DM); u32x4* d0 = (u32x4*)(HS + (size_t)p0 * DM); u32x4* d1 = (u32x4*)(HS + (size_t)p1 * DM);
#pragma unroll
                    for (int j = 0; j < 4; ++j) { const u32x4 w = __builtin_nontemporal_load(src + lane + 64 * j); d0[lane + 64 * j] = w; d1[lane + 64 * j] = w; }
                }
                for (int e = 0; e < 8; ++e) { const int st = T[e] + T[16 + e], en = T[e + 1];
                    for (int r = st + gw; r < en; r += NGW) { u32x4* d0 = (u32x4*)(HS + (size_t)r * DM);
#pragma unroll
                        for (int j = 0; j < 4; ++j) d0[lane + 64 * j] = (u32x4){0u, 0u, 0u, 0u}; } }
            }
            SEAM(PB + 6);
        }

        if (IN(PB + 7) || IN(PB + 8)) {
            PHASE_LOCALS
            LAS int* T = (LAS int*)(L + LDSCTL_OFF);
            if (l == 0) { __syncthreads(); if (tid < 72) T[64 + tid] = 0; if (tid == 0) T[32] = NLAT / 256; __syncthreads(); }
            else moe_tables(ws, L + LDSCTL_OFF, L, false, G);
        }
        if (IN(PB + 7)) for (int rep_ = 0; rep_ < REP_K7; ++rep_) {
            const LAS int* T = (const LAS int*)(L + LDSCTL_OFF);
            pg8::Gemm g{l == 0 ? H : HS, l == 0 ? WGU : MGU, DM, DM, DM};
            const int units7 = T[32] * 56, left7 = units7 - (units7 / G) * G; const bool wide7 = l == 1 && left7 > 0 && left7 <= WIDE_MAX;
            pg8::SchedMoe S{T[32], 56, G, bx, DM, DM, 128, (long)2 * DFF * DM, T + 64, wide7 ? units7 - left7 : 1 << 30};
            pg8::EpiSwiglu E{l == 0 ? ACT : MACT, DFF};
#ifndef NO_G7
            pg8::gemm_phase<pg8::EpiSwiglu, pg8::SchedMoe, true>(L, g, S, E);
#endif
            { PHASE_LOCALS
              if (l == 0) pg8::ctx_gemm_wide<1>(H + (size_t)NLAT * DM, DM, WGU, DM, DM, 224, 1, ACT + (size_t)NLAT * DFF, DFF, L, tid, vcu, G);
              else if (wide7) pg8::ctx_gemm_wide<1>(HS, DM, MGU, DM, DM, 0, 0, MACT, DFF, L, tid, vcu, G, T + 64, T[32], units7 - left7, (long)2 * DFF * DM, left7);
            }
        }
        SEAM(PB + 7);
        if (IN(PB + 8)) for (int rep_ = 0; rep_ < REP_K8; ++rep_) {
            const LAS int* T = (const LAS int*)(L + LDSCTL_OFF);
            pg8::Gemm g{l == 0 ? ACT : MACT, l == 0 ? WDN : MDN, DFF, DFF, DFF};
            const int dn_first = 2 * G;
            pg8::SchedMoe S{T[32], 8, G, bx, DFF, DFF, 256, (long)DM * DFF, T + 64, dn_first};
            pg8::EpiBf16 E{l == 0 ? O : DOUT, DM, O, DM};
#ifndef NO_G8
            pg8::gemm_phase<pg8::EpiBf16, pg8::SchedMoe, true>(L, g, S, E);
#endif
            if (l == 1 && T[32] * 8 > dn_first) {
                const int R = T[32] * 8 - dn_first;
                const int nsl = 14 * R <= G ? 14 : 8 * R <= G ? 8 : 7 * R <= G ? 7 : 4;
                if (threadIdx.x == 0) for (int Lt = bx; Lt < nsl * R; Lt += G) if (Lt % nsl == 0) { int p_, pn_; pg8::moe_map(dn_first + Lt / nsl, T[32], 8, p_, pn_); ctl[CW_TAIL + p_ * 8 + pn_] = ((unsigned)(Lt / nsl) + 1u) | ((unsigned)nsl << 16); }
                pg8::Gemm g2{MACT, MDN, DFF, DFF, DFF / nsl}; pg8::SchedMoeTail S2{T[32], 8, G, bx, DFF, DFF, (long)DM * DFF, T + 64, dn_first, DFF / nsl, nsl};
                pg8::EpiF32 E2{(float*)(ws + WS_PART), 256};
                pg8::gemm_phase<pg8::EpiF32, pg8::SchedMoeTail, true>(L, g2, S2, E2);
            }
            if (l == 0) { PHASE_LOCALS
                pg8::ctx_gemm_wide<3>(ACT + (size_t)NLAT * DFF, DFF, WDN, DFF, DFF / 7, 32, 7, ws + WS_PART, DM, L, tid, vcu, G);
            }
        }
        SEAM(PB + 8);

        if (IN(PB + 9)) {
            PHASE_LOCALS
            LAS float* vv = (LAS float*)L;
            __syncthreads();
            for (int i = tid; i < 2 * DM; i += NTHREADS) { const int v = i >> 11, c = i & (DM - 1);
                vv[(v * 3 + 0) * DM + c] = modp(ws, l, v, 5)[c] * g_post_ffn[l * DM + c];
                if (l == 0) { vv[(v * 3 + 1) * DM + c] = g_pre_mix[DM + c] * (1.0f + modp(ws, 1, v, 1)[c]); vv[(v * 3 + 2) * DM + c] = modp(ws, 1, v, 0)[c]; } }
            __syncthreads();
            for (int row = gw; row < nrows; row += NGW) {
                const int v = row >= NLAT;
                f32x4 ov[8], xv[8];
                if (l == 0) {
                    if (v) { const float* cp = (const float*)(ws + WS_PART) + (size_t)(row - NLAT) * DM;
                        ld_row_f32(cp, lane, ov);
                        for (int ks = 1; ks < 7; ++ks) { f32x4 t_[8]; ld_row_f32(cp + (size_t)ks * NCTX * DM, lane, t_);
#pragma unroll
                            for (int j = 0; j < 8; ++j) ov[j] += t_[j]; } }
                    else ld_row_bf16(O + (size_t)row * DM, lane, ov); }
                else { const unsigned p0 = TOK[(size_t)row * 8 + 6], p1 = TOK[(size_t)row * 8 + 7]; const float w0 = __uint_as_float(TOK[(size_t)row * 8 + 4]), w1 = __uint_as_float(TOK[(size_t)row * 8 + 5]);
                    f32x4 o1[8]; ld_row_bf16(DOUT + (size_t)p0 * DM, lane, ov); ld_row_bf16(DOUT + (size_t)p1 * DM, lane, o1);
                    const float* PART = (const float*)(ws + WS_PART);
                    const u32x4* tf0 = (const u32x4*)(ctl + CW_TAIL + (p0 >> 8) * 8); const u32x4* tf1 = (const u32x4*)(ctl + CW_TAIL + (p1 >> 8) * 8);
                    const u32x4 f0a = tf0[0], f0b = tf0[1], f1a = tf1[0], f1b = tf1[1];
                    if ((f0a.x | f0a.y | f0a.z | f0a.w | f0b.x | f0b.y | f0b.z | f0b.w | f1a.x | f1a.y | f1a.z | f1a.w | f1b.x | f1b.y | f1b.z | f1b.w) != 0u) {
#pragma unroll
                        for (int j = 0; j < 8; ++j) {
                            const unsigned t0 = __builtin_amdgcn_readfirstlane(j < 4 ? f0a[j & 3] : f0b[j & 3]), t1 = __builtin_amdgcn_readfirstlane(j < 4 ? f1a[j & 3] : f1b[j & 3]);
                            if (t0) { const int ns_ = (int)(t0 >> 16), ub_ = (int)((t0 & 0xffffu) - 1u) * ns_; f32x4 a = {0.f, 0.f, 0.f, 0.f}; for (int ks = 0; ks < ns_; ++ks) a += *(const f32x4*)(PART + ((size_t)(ub_ + ks) * 256 + (p0 & 255)) * 256 + 4 * lane); ov[j] = a; }
                            if (t1) { const int ns_ = (int)(t1 >> 16), ub_ = (int)((t1 & 0xffffu) - 1u) * ns_; f32x4 a = {0.f, 0.f, 0.f, 0.f}; for (int ks = 0; ks < ns_; ++ks) a += *(const f32x4*)(PART + ((size_t)(ub_ + ks) * 256 + (p1 & 255)) * 256 + 4 * lane); o1[j] = a; }
                        }
                    }
#pragma unroll
                    for (int j = 0; j < 8; ++j) ov[j] = ov[j] * w0 + o1[j] * w1; }
                ld_row_f32_nt(X + (size_t)row * DM, lane, xv);
                const float r1 = __builtin_amdgcn_rsqf(row_sumsq(ov) * (1.0f / DM) + EPS);
                const LAS f32x4* GG = (const LAS f32x4*)(vv + (v * 3 + 0) * DM) + lane;
#pragma unroll
                for (int j = 0; j < 8; ++j) xv[j] = xv[j] + ov[j] * r1 * GG[64 * j];
                if (l == 0) {
                    st_row_f32_nt(X + (size_t)row * DM, lane, xv);
                    const LAS f32x4* A2 = (const LAS f32x4*)(vv + (v * 3 + 1) * DM) + lane; const LAS f32x4* B2 = (const LAS f32x4*)(vv + (v * 3 + 2) * DM) + lane;
                    const float r2 = __builtin_amdgcn_rsqf(row_sumsq(xv) * (1.0f / DM) + EPS);
#pragma unroll
                    for (int j = 0; j < 8; ++j) xv[j] = xv[j] * r2 * A2[64 * j] + B2[64 * j];
                    st_row_bf16(H + (size_t)row * DM, lane, xv);
                } else st_row_f32_nt(args.out + (size_t)row * DM, lane, xv);
            }
        }
        if (l == 0) SEAM(PB + 9);
    }
#undef IN
#undef SEAM
}

extern "C" void kernel_launch(void* const* d_in, const int* in_sizes, int n_in, void* d_out, int out_size, void* d_ws, size_t ws_size, hipStream_t stream) {
    static int grid = 0;
    if (grid == 0) {
        if (n_in != 27 || out_size != NLAT * DM || ws_size < WS_END) { fprintf(stderr, "kernel_launch: unexpected shapes (n_in %d out %d ws %zu)\n", n_in, out_size, ws_size); grid = -1; return; }
        int dev = 0, cus = 0, per_cu = 0;
        if (hipGetDevice(&dev) != hipSuccess || hipDeviceGetAttribute(&cus, hipDeviceAttributeMultiprocessorCount, dev) != hipSuccess) { grid = -1; return; }
        if (hipFuncSetAttribute((const void*)fwd_kernel, hipFuncAttributeMaxDynamicSharedMemorySize, LDS_BYTES) != hipSuccess) { fprintf(stderr, "kernel_launch: hipFuncSetAttribute failed\n"); grid = -1; return; }
        if (hipOccupancyMaxActiveBlocksPerMultiprocessor(&per_cu, (const void*)fwd_kernel, NTHREADS, LDS_BYTES) != hipSuccess || per_cu < 1) { fprintf(stderr, "kernel_launch: occupancy query says %d\n", per_cu); (void)hipGetLastError(); per_cu = 1; }
        grid = cus > 256 ? 256 : cus;
    }
    if (grid < 0) return;
    (void)hipMemsetAsync((char*)d_ws + WS_CTL, 0, CTL_ZERO_BYTES, stream);
    Args a{};
    for (int i = 0; i < 27; ++i) a.in[i] = (const float*)d_in[i];
    a.out = (float*)d_out; a.ws = (unsigned char*)d_ws; a.ph_lo = 0; a.ph_hi = 1000;
    hipLaunchKernelGGL(fwd_kernel, dim3(grid), dim3(NTHREADS), LDS_BYTES, stream, a);
}
```

```cpp
#include <hip/hip_runtime.h>
#include <hip/hip_bf16.h>
#include <cstdio>
#include <cstdint>
#include <cmath>
namespace pg8 {
#define PG8_LAS __attribute__((address_space(3)))
typedef unsigned short bf16_t;
typedef short bf16x8 __attribute__((ext_vector_type(8)));
typedef float f32x4 __attribute__((ext_vector_type(4)));
typedef unsigned u32x4 __attribute__((ext_vector_type(4)));
constexpr int BM = 256, BK = 64, HALF = 128, HTB = HALF * BK * 2, STAGE_BYTES = 8 * HTB, NXCD = 8, WGM = 8;

__host__ __device__ __forceinline__ int lds_byte(int r, int c) { const int st = (r >> 4) * 2 + (c >> 5), rr = r & 15, cc = c & 31, ob = rr * 64 + cc * 2; return st * 1024 + (ob ^ (((ob >> 9) & 1) << 5)); }
__host__ __device__ __forceinline__ void stage_rc(int b, int& R, int& C) { const int st = b / 1024, sb = b % 1024, swz = sb ^ (((sb >> 9) & 1) << 5); R = (st >> 1) * 16 + swz / 64; C = (st & 1) * 32 + (swz % 64) / 2; }
__host__ __device__ __forceinline__ int perm32(int rho) { const int n = rho >> 4, i = rho & 15; return 8 * (i >> 2) + 4 * n + (i & 3); }

struct Unit { long aoff, boff; int orow, ocol, sel; };
struct Gemm { const bf16_t* A; const bf16_t* Bt; int lda, ldb, K; };

typedef float f32x2_t __attribute__((ext_vector_type(2))); typedef __bf16 bf16x2_t __attribute__((ext_vector_type(2)));
__device__ __forceinline__ unsigned cvt_pk_bf16(float lo, float hi) { f32x2_t v = {lo, hi}; bf16x2_t b = __builtin_convertvector(v, bf16x2_t); return __builtin_bit_cast(unsigned, b); }

template <bool XSW> __device__ __forceinline__ f32x4 xsw4(f32x4 v, int fq) {
    if (!XSW) return v; const bool o = (fq & 1) != 0; return (f32x4){o ? v[1] : v[0], o ? v[0] : v[1], o ? v[3] : v[2], o ? v[2] : v[3]}; }
template <bool XSW = false> struct EpiBf16T {
    static constexpr bool PERM = true;
    bf16_t* O0; int ldc0; bf16_t* O1; int ldc1;
    template <class UU> __device__ __forceinline__ void operator()(const f32x4 (&acc)[2][2][4][2], const UU& u, int wr, int wc, int fr, int fq) const {
        bf16_t* O = u.sel ? O1 : O0; const int ldc = u.sel ? ldc1 : ldc0;
        const int row0 = u.orow + wr * 64 + fr, col0 = u.ocol + wc * 32 + 8 * fq;
#pragma unroll
        for (int ai = 0; ai < 2; ++ai)
#pragma unroll
            for (int m = 0; m < 4; ++m) { bf16_t* rowp = O + (size_t)(row0 + ai * HALF + m * 16) * ldc + col0;
#pragma unroll
                for (int bj = 0; bj < 2; ++bj) { const f32x4 v0 = xsw4<XSW>(acc[ai][bj][m][0], fq), v1 = xsw4<XSW>(acc[ai][bj][m][1], fq);
                    u32x4 w; w.x = cvt_pk_bf16(v0[0], v0[1]); w.y = cvt_pk_bf16(v0[2], v0[3]); w.z = cvt_pk_bf16(v1[0], v1[1]); w.w = cvt_pk_bf16(v1[2], v1[3]);
                    *(u32x4*)(rowp + bj * HALF) = w; } }
    }
};
typedef EpiBf16T<false> EpiBf16;
__device__ __forceinline__ float silu_mul(float g, float u) { return g * u * __builtin_amdgcn_rcpf(1.0f + __builtin_amdgcn_exp2f(-1.4426950408889634f * g)); }
template <bool XSW = false> struct EpiSwigluT {
    static constexpr bool PERM = true;
    bf16_t* O; int ldc;
    template <class UU> __device__ __forceinline__ void operator()(const f32x4 (&acc)[2][2][4][2], const UU& u, int wr, int wc, int fr, int fq) const {
        const int row0 = u.orow + wr * 64 + fr, col0 = u.ocol + wc * 32 + 8 * fq;
#pragma unroll
        for (int ai = 0; ai < 2; ++ai)
#pragma unroll
            for (int m = 0; m < 4; ++m) { bf16_t* rowp = O + (size_t)(row0 + ai * HALF + m * 16) * ldc + col0;
                const f32x4 g0 = xsw4<XSW>(acc[ai][0][m][0], fq), g1 = xsw4<XSW>(acc[ai][0][m][1], fq), u0 = xsw4<XSW>(acc[ai][1][m][0], fq), u1 = xsw4<XSW>(acc[ai][1][m][1], fq);
                u32x4 w; w.x = cvt_pk_bf16(silu_mul(g0[0], u0[0]), silu_mul(g0[1], u0[1])); w.y = cvt_pk_bf16(silu_mul(g0[2], u0[2]), silu_mul(g0[3], u0[3]));
                w.z = cvt_pk_bf16(silu_mul(g1[0], u1[0]), silu_mul(g1[1], u1[1])); w.w = cvt_pk_bf16(silu_mul(g1[2], u1[2]), silu_mul(g1[3], u1[3]));
                *(u32x4*)rowp = w; }
    }
};
typedef EpiSwigluT<false> EpiSwiglu;
struct EpiF32 {
    static constexpr bool PERM = false;
    float* O; int ldc;
    template <class UU> __device__ __forceinline__ void operator()(const f32x4 (&acc)[2][2][4][2], const UU& u, int wr, int wc, int fr, int fq) const {
        const int row0 = u.orow + wr * 64 + fr, col0 = u.ocol + wc * 32 + 4 * fq;
#pragma unroll
        for (int ai = 0; ai < 2; ++ai)
#pragma unroll
            for (int m = 0; m < 4; ++m) { float* rowp = O + (size_t)(row0 + ai * HALF + m * 16) * ldc + col0;
#pragma unroll
                for (int bj = 0; bj < 2; ++bj)
#pragma unroll
                    for (int n = 0; n < 2; ++n) *(f32x4*)(rowp + bj * HALF + n * 16) = acc[ai][bj][m][n]; }
    }
};

template <class Epi, class Sched, bool ALIGN_EPI, bool KBLK = false>
__device__ __forceinline__ void gemm_phase(PG8_LAS unsigned char* lds, const Gemm g, const Sched& S, const Epi& E) {
    int tid_ = threadIdx.x; asm volatile("" : "+v"(tid_));
    const int tid = tid_, wid = __builtin_amdgcn_readfirstlane(tid >> 6), lane = tid & 63, wr = wid >> 2, wc = wid & 3, fr = lane & 15, fq = lane >> 4;
    const int K = g.K, nt = K / BK;
    unsigned voffA[2], voffB[2];
#pragma unroll
    for (int i = 0; i < 2; ++i) { int R, C; stage_rc(tid * 16 + i * 8192, R, C); const int Rb = Epi::PERM ? ((R & ~31) + perm32(R & 31)) : R;
        voffA[i] = (unsigned)(R * g.lda + C) * 2u; voffB[i] = KBLK ? (unsigned)((C >> 3) * g.ldb + Rb) * 16u : (unsigned)(Rb * g.ldb + C) * 2u; }
    const size_t kstep = (size_t)(BK * 2);
    const size_t hstepA = (size_t)HALF * g.lda * 2, hstepB = KBLK ? (size_t)HALF * 16 : (size_t)HALF * g.ldb * 2;
    const size_t kstepB = KBLK ? (size_t)8 * g.ldb * 16 : kstep;
    const unsigned ldsw = (unsigned)wid * 1024u;
    const int aoff = lds_byte(wr * 64 + fr, fq * 8), boff = lds_byte(wc * 32 + fr, fq * 8);
#define PG8_SA(b, h) (((b) * 2 + (h)) * HTB)
#define PG8_SB(b, h) ((4 + (b) * 2 + (h)) * HTB)
#define PG8_STAGE(bufoff, gbase, voff) do { _Pragma("unroll") for (int _i = 0; _i < 2; ++_i) \
        __builtin_amdgcn_global_load_lds((const unsigned*)((const char*)(gbase) + (voff)[_i]), (PG8_LAS unsigned*)(lds + (bufoff) + ldsw + _i * 8192), 16, 0, 0); } while (0)
#define PG8_LDA(dst, b, h) do { _Pragma("unroll") for (int m = 0; m < 4; ++m) _Pragma("unroll") for (int k = 0; k < 2; ++k) dst[m][k] = *(const PG8_LAS bf16x8*)(lds + PG8_SA(b, h) + aoff + m * 2048 + k * 1024); } while (0)
#define PG8_LDB(dst, b, h) do { _Pragma("unroll") for (int n = 0; n < 2; ++n) _Pragma("unroll") for (int k = 0; k < 2; ++k) dst[n][k] = *(const PG8_LAS bf16x8*)(lds + PG8_SB(b, h) + boff + n * 2048 + k * 1024); } while (0)
#define PG8_MMA(ai, bj, At, Bt) do { __builtin_amdgcn_s_setprio(1); _Pragma("unroll") for (int m = 0; m < 4; ++m) _Pragma("unroll") for (int n = 0; n < 2; ++n) _Pragma("unroll") for (int k = 0; k < 2; ++k) \
        acc[ai][bj][m][n] = __builtin_amdgcn_mfma_f32_16x16x32_bf16(Bt[n][k], At[m][k], acc[ai][bj][m][n], 0, 0, 0); __builtin_amdgcn_s_setprio(0); } while (0)
#define PG8_WAIT_V(n) asm volatile("s_waitcnt vmcnt(" #n ")" ::: "memory")
#define PG8_WAIT_L(n) asm volatile("s_waitcnt lgkmcnt(" #n ")" ::: "memory")
#define PG8_BAR __builtin_amdgcn_s_barrier()
#define PG8_SCHED __builtin_amdgcn_sched_barrier(0)
    Unit cur, nxt; int ui = 0;
    if (!S.next(0, cur)) return;
    f32x4 acc[2][2][4][2];
#pragma unroll
    for (int a = 0; a < 2; ++a)
#pragma unroll
        for (int b = 0; b < 2; ++b)
#pragma unroll
            for (int m = 0; m < 4; ++m)
#pragma unroll
                for (int n = 0; n < 2; ++n) acc[a][b][m][n] = (f32x4){0.f, 0.f, 0.f, 0.f};
    bf16x8 At[4][2], B0[2][2], B1[2][2];
    const char* cA = (const char*)g.A + (size_t)cur.aoff * 2; const char* cB = (const char*)g.Bt + (size_t)cur.boff * 2;
    PG8_STAGE(PG8_SB(0, 0), cB, voffB); PG8_STAGE(PG8_SB(0, 1), cB + hstepB, voffB); PG8_STAGE(PG8_SA(0, 0), cA, voffA); PG8_STAGE(PG8_SA(0, 1), cA + hstepA, voffA);
    if (wr == 1) PG8_BAR;
    PG8_WAIT_V(2); PG8_BAR;
    PG8_STAGE(PG8_SB(1, 0), cB + kstepB, voffB); PG8_STAGE(PG8_SA(1, 0), cA + kstep, voffA); PG8_STAGE(PG8_SB(1, 1), cB + hstepB + kstepB, voffB);
    PG8_WAIT_V(6); PG8_BAR;
    for (;;) {
        const bool has_next = S.next(ui + 1, nxt);
        const char* nA = has_next ? (const char*)g.A + (size_t)nxt.aoff * 2 : cA; const char* nB = has_next ? (const char*)g.Bt + (size_t)nxt.boff * 2 : cB;
        for (int t = 0; t < nt; t += 2) {
            const bool last = (t == nt - 2);
            const char* a1 = cA + (size_t)(t + 1) * kstep;
            const char* a2 = last ? nA : cA + (size_t)(t + 2) * kstep; const char* b2 = last ? nB : cB + (size_t)(t + 2) * kstepB;
            const char* a3 = a2 + kstep; const char* b3 = b2 + kstepB;
            PG8_LDB(B0, 0, 0); PG8_LDB(B1, 0, 1); PG8_SCHED; PG8_LDA(At, 0, 0); PG8_STAGE(PG8_SA(1, 1), a1 + hstepA, voffA);
            PG8_WAIT_V(8); PG8_WAIT_L(0); PG8_BAR; PG8_MMA(0, 0, At, B0); PG8_MMA(0, 1, At, B1); PG8_BAR; PG8_SCHED;
            PG8_LDA(At, 0, 1); PG8_STAGE(PG8_SB(0, 0), b2, voffB); PG8_STAGE(PG8_SB(0, 1), b2 + hstepB, voffB); PG8_STAGE(PG8_SA(0, 0), a2, voffA);
            PG8_WAIT_V(8); PG8_WAIT_L(0); PG8_BAR; PG8_MMA(1, 0, At, B0); PG8_MMA(1, 1, At, B1); PG8_BAR; PG8_SCHED;
            PG8_LDB(B0, 1, 0); PG8_LDB(B1, 1, 1); PG8_SCHED; PG8_LDA(At, 1, 0); PG8_STAGE(PG8_SA(0, 1), a2 + hstepA, voffA);
            PG8_WAIT_V(8); PG8_WAIT_L(0); PG8_BAR; PG8_MMA(0, 0, At, B0); PG8_MMA(0, 1, At, B1); PG8_BAR; PG8_SCHED;
            PG8_LDA(At, 1, 1); PG8_STAGE(PG8_SB(1, 0), b3, voffB); PG8_STAGE(PG8_SB(1, 1), b3 + hstepB, voffB); PG8_STAGE(PG8_SA(1, 0), a3, voffA);
            PG8_WAIT_V(8); PG8_WAIT_L(0); PG8_BAR; PG8_MMA(1, 0, At, B0); PG8_MMA(1, 1, At, B1); PG8_BAR; PG8_SCHED;
        }
        if constexpr (ALIGN_EPI) { if (wr == 0) PG8_BAR; }
        E(acc, cur, wr, wc, fr, fq);
        if (!has_next) break;
#pragma unroll
        for (int a = 0; a < 2; ++a)
#pragma unroll
            for (int b = 0; b < 2; ++b)
#pragma unroll
                for (int m = 0; m < 4; ++m)
#pragma unroll
                    for (int n = 0; n < 2; ++n) acc[a][b][m][n] = (f32x4){0.f, 0.f, 0.f, 0.f};
        cur = nxt; cA = nA; cB = nB; ++ui;
        if constexpr (ALIGN_EPI) { if (wr == 1) PG8_BAR; }
    }
    PG8_WAIT_V(0);
    if constexpr (!ALIGN_EPI) { if (wr == 0) PG8_BAR; }
    PG8_BAR;
#undef PG8_SA
#undef PG8_SB
#undef PG8_STAGE
#undef PG8_LDA
#undef PG8_LDB
#undef PG8_MMA
#undef PG8_WAIT_V
#undef PG8_WAIT_L
#undef PG8_BAR
#undef PG8_SCHED
}

struct SchedIn {
    int G, c, nextra, pn0;
    __device__ __forceinline__ bool next(int i, Unit& u) const {
        const int L = i * G + c; int pm, pn;
        if (L < 384) { constexpr int nwg = 384, nN = 12, nM = 32;
            int wgid = L; { const int q = nwg / NXCD, r = nwg % NXCD, xcd = wgid % NXCD, off = wgid / NXCD; wgid = (xcd < r ? xcd * (q + 1) : r * (q + 1) + (xcd - r) * q) + off; }
            const int nig = WGM * nN, gid = wgid / nig, fm = gid * WGM, gsz = (nM - fm) < WGM ? (nM - fm) : WGM;
            pm = fm + ((wgid % nig) % gsz); pn = (wgid % nig) / gsz;
        } else { const int j = L - 384; if (j >= nextra) return false; pm = 32; pn = pn0 + j; }
        u.aoff = (long)pm * BM * 2048; u.boff = (long)pn * BM * 2048; u.orow = pm * BM; u.ocol = pn * BM; u.sel = 0; return true;
    }
};
struct SchedZW {
    int G, c;
    __device__ __forceinline__ bool next(int i, Unit& u) const {
        const int L = i * G + c; if (L >= 128) return false;
        const int pm = L & 3, pn = L >> 2, n2 = pn >> 1, h = pn & 1;
        u.aoff = (long)pm * BM * 2048; u.boff = (long)(4096 * h + n2) * 2048; u.orow = (pm & 1) * BM; u.ocol = n2 * 1024 + (pm >> 1) * 512 + h * 256; u.sel = 0; return true;
    }
};
struct SchedTiles {
    int nM, nN, nwg, G, c, lda, ldb, ocw;
    __device__ __forceinline__ bool next(int i, Unit& u) const {
        const int L = i * G + c; if (L >= nwg) return false;
        int wgid = L; { const int q = nwg / NXCD, r = nwg % NXCD, xcd = wgid % NXCD, off = wgid / NXCD; wgid = (xcd < r ? xcd * (q + 1) : r * (q + 1) + (xcd - r) * q) + off; }
        const int nig = WGM * nN, gid = wgid / nig, fm = gid * WGM, gsz = (nM - fm) < WGM ? (nM - fm) : WGM;
        const int pm = fm + ((wgid % nig) % gsz), pn = (wgid % nig) / gsz;
        u.aoff = (long)pm * BM * lda; u.boff = (long)pn * BM * ldb; u.orow = pm * BM; u.ocol = pn * ocw; u.sel = 0; return true;
    }
};
struct SchedF1 {
    int G, c;
    __device__ __forceinline__ bool next(int i, Unit& u) const {
        const int L = i * G + c; if (L >= 128) return false;
        const int n2 = L >> 3, mt = (L >> 1) & 3, dt = L & 1;
        u.aoff = (long)mt * BM * 1024; u.boff = (long)dt * BM * 16384 + n2 * 1024; u.orow = n2 * 1024 + mt * BM; u.ocol = dt * BM; u.sel = 0; return true;
    }
};
__device__ __forceinline__ void moe_map(int L, int npan, int nN, int& p, int& pn) {
    const int nwg = npan * nN;
    int wgid = L; { const int q = nwg / NXCD, r = nwg % NXCD, xcd = wgid % NXCD, off = wgid / NXCD; wgid = (xcd < r ? xcd * (q + 1) : r * (q + 1) + (xcd - r) * q) + off; }
    const int nig = WGM * nN, gid = wgid / nig, fm = gid * WGM, gsz = (npan - fm) < WGM ? (npan - fm) : WGM;
    p = fm + ((wgid % nig) % gsz); pn = (wgid % nig) / gsz;
}
struct SchedMoe {
    int npan, nN, G, c, lda, ldb, ocw; long estride; const PG8_LAS int* pe; int lim;
    __device__ __forceinline__ bool next(int i, Unit& u) const {
        const int L = i * G + c; const int nwg = npan * nN; if (L >= nwg || L >= lim) return false;
        int p, pn; moe_map(L, npan, nN, p, pn); const int e = pe[p];
        u.aoff = (long)p * BM * lda; u.boff = (long)e * estride + (long)pn * BM * ldb; u.orow = p * BM; u.ocol = pn * ocw; u.sel = 0; return true;
    }
};
struct SchedMoeTail {
    int npan, nN, G, c, lda, ldb; long estride; const PG8_LAS int* pe; int first, ksl, nsl;
    __device__ __forceinline__ bool next(int i, Unit& u) const {
        const int Lt = i * G + c; const int R = npan * nN - first; if (Lt >= nsl * R) return false;
        const int un = Lt / nsl, ks = Lt - un * nsl;
        int p, pn; moe_map(first + un, npan, nN, p, pn); const int e = pe[p];
        u.aoff = (long)p * BM * lda + ks * ksl; u.boff = (long)e * estride + (long)pn * BM * ldb + ks * ksl; u.orow = Lt * BM; u.ocol = 0; u.sel = 0; return true;
    }
};

template <int EPI, bool KBLK = false>
__device__ __forceinline__ void ctx_gemm(const bf16_t* __restrict__ A, int lda, const bf16_t* __restrict__ Bt, int ldb, int K, int ntn, int brow0,
                                         bf16_t* __restrict__ O, int ldo, int ocol0, PG8_LAS unsigned char* lds, int tid, int vcu, int G) {
    typedef unsigned u32x2_ __attribute__((ext_vector_type(2)));
    constexpr int LROW = 144;
    const int lane = tid & 63, w = __builtin_amdgcn_readfirstlane(tid >> 6), fr = lane & 15, fq = lane >> 4, mb = w >> 1, h = w & 1;
    const int srow = tid >> 3, skc = (tid & 7) * 8;
    const int nb0 = (EPI == 1) ? h : 2 * h, nb1 = (EPI == 1) ? 2 + h : 2 * h + 1;
    for (int tile = vcu; tile < 4 * ntn; tile += G) {
        const int tm = tile & 3, tn = tile >> 2;
        int brow;
        if (EPI == 1) brow = (tn >> 2) * 256 + (tn & 3) * 32 + (srow < 32 ? srow : 128 + srow - 32); else brow = brow0 + tn * 64 + srow;
        const bf16_t* ga = A + (size_t)(tm * 64 + srow) * lda + skc;
        const bf16_t* gb = KBLK ? Bt + ((size_t)(skc >> 3) * ldb + brow) * 8 : Bt + (size_t)brow * ldb + skc;
        const size_t bch = KBLK ? (size_t)64 * ldb : 64;
        f32x4 acc0 = {0.f, 0.f, 0.f, 0.f}, acc1 = {0.f, 0.f, 0.f, 0.f};
        constexpr int PD = 8;
        u32x4 ra[PD], rb[PD];
#pragma unroll
        for (int j = 0; j < PD; ++j) { ra[j] = *(const u32x4*)(ga + (size_t)j * 64); rb[j] = *(const u32x4*)(gb + (size_t)j * bch); }
        const int nch = K / 64;
        __syncthreads();
        for (int c = 0; c < nch; c += PD) {
#pragma unroll
            for (int j = 0; j < PD; ++j) {
                PG8_LAS unsigned char* sa = lds + (j & 1) * (2 * 64 * LROW); PG8_LAS unsigned char* sb = sa + 64 * LROW;
                *(PG8_LAS u32x4*)(sa + srow * LROW + skc * 2) = ra[j]; *(PG8_LAS u32x4*)(sb + srow * LROW + skc * 2) = rb[j];
                __syncthreads();
                if (c + j + PD < nch) { ra[j] = *(const u32x4*)(ga + (size_t)(c + j + PD) * 64); rb[j] = *(const u32x4*)(gb + (size_t)(c + j + PD) * bch); }
#pragma unroll
                for (int ks = 0; ks < 2; ++ks) {
                    const bf16x8 af = *(const PG8_LAS bf16x8*)(sa + (mb * 16 + fr) * LROW + (ks * 32 + fq * 8) * 2);
                    const bf16x8 b0 = *(const PG8_LAS bf16x8*)(sb + (nb0 * 16 + fr) * LROW + (ks * 32 + fq * 8) * 2);
                    const bf16x8 b1 = *(const PG8_LAS bf16x8*)(sb + (nb1 * 16 + fr) * LROW + (ks * 32 + fq * 8) * 2);
                    acc0 = __builtin_amdgcn_mfma_f32_16x16x32_bf16(b0, af, acc0, 0, 0, 0);
                    acc1 = __builtin_amdgcn_mfma_f32_16x16x32_bf16(b1, af, acc1, 0, 0, 0);
                }
            }
        }
        const int row = tm * 64 + mb * 16 + fr;
        if (EPI == 0) {
            u32x2_ w0, w1; w0.x = cvt_pk_bf16(acc0[0], acc0[1]); w0.y = cvt_pk_bf16(acc0[2], acc0[3]); w1.x = cvt_pk_bf16(acc1[0], acc1[1]); w1.y = cvt_pk_bf16(acc1[2], acc1[3]);
            bf16_t* op = O + (size_t)row * ldo + ocol0 + tn * 64 + 4 * fq;
            *(u32x2_*)(op + nb0 * 16) = w0; *(u32x2_*)(op + nb1 * 16) = w1;
        } else if (EPI == 1) {
            u32x2_ wv; wv.x = cvt_pk_bf16(silu_mul(acc0[0], acc1[0]), silu_mul(acc0[1], acc1[1])); wv.y = cvt_pk_bf16(silu_mul(acc0[2], acc1[2]), silu_mul(acc0[3], acc1[3]));
            *(u32x2_*)(O + (size_t)row * ldo + tn * 32 + h * 16 + 4 * fq) = wv;
        } else {
#pragma unroll
            for (int i = 0; i < 4; ++i) { const int d0 = tn * 64 + nb0 * 16 + 4 * fq + i, d1 = tn * 64 + nb1 * 16 + 4 * fq + i;
                O[(size_t)(d0 & 511) * 512 + (d0 >> 9) * 256 + row] = (bf16_t)(cvt_pk_bf16(acc0[i], 0.f) & 0xffffu);
                O[(size_t)(d1 & 511) * 512 + (d1 >> 9) * 256 + row] = (bf16_t)(cvt_pk_bf16(acc1[i], 0.f) & 0xffffu); }
        }
    }
    __syncthreads();
}

template <int EPI>
__device__ __forceinline__ void ctx_gemm_wide(const bf16_t* __restrict__ A, int lda, const bf16_t* __restrict__ Bt, int ldb, int Ks, int ntn, int nks,
                                              void* __restrict__ Ov, int ldo, PG8_LAS unsigned char* lds, int tid, int vcu, int G,
                                              const PG8_LAS int* pe = nullptr, int npan = 0, int first = 0, long estride = 0, int nleft = 0) {
    typedef unsigned u32x2_ __attribute__((ext_vector_type(2)));
    constexpr int LROW = 144;
    const int lane = tid & 63, w = __builtin_amdgcn_readfirstlane(tid >> 6), fr = lane & 15, fq = lane >> 4;
    const int srow = tid >> 3, skc = (tid & 7) * 8;
    const int nitems = pe ? 4 * nleft : ntn * nks;
    for (int item = vcu; item < nitems; item += G) {
        int tn, ks; const bf16_t* Ai = A; const bf16_t* Bi = Bt; void* Oi = Ov;
        if (pe) { int p_, pn_; moe_map(first + (item >> 2), npan, 56, p_, pn_); tn = pn_ * 4 + (item & 3); ks = 0;
                  Ai = A + (size_t)p_ * 256 * lda; Bi = Bt + (size_t)pe[p_] * estride; Oi = (bf16_t*)Ov + (size_t)p_ * 256 * ldo; }
        else { tn = item % ntn; ks = item / ntn; }
        const int brow = (EPI == 1) ? (tn >> 2) * 256 + (tn & 3) * 32 + (srow < 32 ? srow : 128 + srow - 32) : tn * 64 + srow;
        const bf16_t* ga = Ai + (size_t)srow * lda + (size_t)ks * Ks + skc;
        const bf16_t* gb = Bi + (size_t)brow * ldb + (size_t)ks * Ks + skc;
        f32x4 acc[2][4];
#pragma unroll
        for (int mi = 0; mi < 2; ++mi)
#pragma unroll
            for (int nb = 0; nb < 4; ++nb) acc[mi][nb] = (f32x4){0.f, 0.f, 0.f, 0.f};
        constexpr int PD = 4;
        u32x4 ra[PD][4], rb[PD];
#pragma unroll
        for (int j = 0; j < PD; ++j) {
#pragma unroll
            for (int q = 0; q < 4; ++q) ra[j][q] = *(const u32x4*)(ga + (size_t)(64 * q) * lda + (size_t)j * 64);
            rb[j] = *(const u32x4*)(gb + (size_t)j * 64); }
        const int nch = Ks / 64;
        __syncthreads();
#define CW_WRITE(slot, buf) do { PG8_LAS unsigned char* sa_ = lds + (buf) * (320 * LROW); PG8_LAS unsigned char* sb_ = sa_ + 256 * LROW; \
            _Pragma("unroll") for (int q = 0; q < 4; ++q) *(PG8_LAS u32x4*)(sa_ + (srow + 64 * q) * LROW + skc * 2) = ra[slot][q]; \
            *(PG8_LAS u32x4*)(sb_ + srow * LROW + skc * 2) = rb[slot]; } while (0)
#define CW_LOAD(slot, ch) do { _Pragma("unroll") for (int q = 0; q < 4; ++q) ra[slot][q] = *(const u32x4*)(ga + (size_t)(64 * q) * lda + (size_t)(ch) * 64); \
            rb[slot] = *(const u32x4*)(gb + (size_t)(ch) * 64); } while (0)
        CW_WRITE(0, 0); if (PD < nch) CW_LOAD(0, PD);
        __syncthreads();
        for (int c = 0; c < nch; c += PD) {
#pragma unroll
            for (int j = 0; j < PD; ++j) {
                const int cc = c + j;
                PG8_LAS unsigned char* sa = lds + (j & 1) * (320 * LROW); PG8_LAS unsigned char* sb = sa + 256 * LROW;
                bf16x8 af[2][2], bfr[2][4];
#pragma unroll
                for (int kst = 0; kst < 2; ++kst) {
#pragma unroll
                    for (int mi = 0; mi < 2; ++mi) af[kst][mi] = *(const PG8_LAS bf16x8*)(sa + ((2 * w + mi) * 16 + fr) * LROW + (kst * 32 + fq * 8) * 2);
#pragma unroll
                    for (int nb = 0; nb < 4; ++nb) bfr[kst][nb] = *(const PG8_LAS bf16x8*)(sb + (nb * 16 + fr) * LROW + (kst * 32 + fq * 8) * 2);
                }
                __builtin_amdgcn_sched_barrier(0);
                if (cc + 1 < nch) { CW_WRITE((j + 1) % PD, (j + 1) & 1); if (cc + 1 + PD < nch) CW_LOAD((j + 1) % PD, cc + 1 + PD); }
                __builtin_amdgcn_sched_barrier(0);
#pragma unroll
                for (int kst = 0; kst < 2; ++kst)
#pragma unroll
                    for (int mi = 0; mi < 2; ++mi)
#pragma unroll
                        for (int nb = 0; nb < 4; ++nb) acc[mi][nb] = __builtin_amdgcn_mfma_f32_16x16x32_bf16(bfr[kst][nb], af[kst][mi], acc[mi][nb], 0, 0, 0);
                __syncthreads();
            }
        }
#undef CW_WRITE
#undef CW_LOAD
#pragma unroll
        for (int mi = 0; mi < 2; ++mi) { const int row = (2 * w + mi) * 16 + fr;
            if (EPI == 1) {
#pragma unroll
                for (int hh = 0; hh < 2; ++hh) { u32x2_ wv; wv.x = cvt_pk_bf16(silu_mul(acc[mi][hh][0], acc[mi][2 + hh][0]), silu_mul(acc[mi][hh][1], acc[mi][2 + hh][1]));
                    wv.y = cvt_pk_bf16(silu_mul(acc[mi][hh][2], acc[mi][2 + hh][2]), silu_mul(acc[mi][hh][3], acc[mi][2 + hh][3]));
                    *(u32x2_*)((bf16_t*)Oi + (size_t)row * ldo + tn * 32 + hh * 16 + 4 * fq) = wv; }
            } else {
#pragma unroll
                for (int nb = 0; nb < 4; ++nb) *(f32x4*)((float*)Oi + ((size_t)ks * 256 + row) * ldo + tn * 64 + nb * 16 + 4 * fq) = acc[mi][nb];
            }
        }
    }
    __syncthreads();
}

}
namespace att {
using bf16 = __hip_bfloat16;
constexpr int D = 128, NW = 8, QBLK = 32, KVBLK = 64;
constexpr float THR = 8.f;
constexpr size_t SHM_V = KVBLK * D * 2, SHM_K = KVBLK * D * 2, SHM_ATTN = 2 * SHM_V + 2 * SHM_K + NW * 64 * 4;
using bf16x8 = __attribute__((ext_vector_type(8))) short;
using s16x4  = __attribute__((ext_vector_type(4))) short;
using f32x16 = __attribute__((ext_vector_type(16))) float;
using u32x4  = __attribute__((ext_vector_type(4))) unsigned;
#define KSWZ(row, colB) ((row) * 256 + ((colB) ^ (((row) & 7) << 4)))
#define SBAR() __builtin_amdgcn_sched_barrier(0)
__device__ __forceinline__ int crow(int r, int hi) { return (r & 3) + 8 * (r >> 2) + 4 * hi; }
__device__ __forceinline__ unsigned cvtpk(float lo, float hi) { unsigned r; asm volatile("v_cvt_pk_bf16_f32 %0, %1, %2" : "=v"(r) : "v"(lo), "v"(hi)); return r; }

__device__ __forceinline__ void expHalf(f32x16& p) { for (int r = 0; r < 16; ++r) p[r] = __builtin_amdgcn_exp2f(p[r]); }
__device__ __forceinline__ void finishSM(f32x16& p0, f32x16& p1, float& l_reg, bf16x8& pa0, bf16x8& pa1, bf16x8& pa2, bf16x8& pa3) {
  for (int r = 0; r < 16; ++r) p1[r] = __builtin_amdgcn_exp2f(p1[r]);
  float ps = 0; for (int r = 0; r < 16; ++r) ps += p0[r]; for (int r = 0; r < 16; ++r) ps += p1[r];
  l_reg += ps;
#define PK4(P, BASE, OUT) do { unsigned a0 = cvtpk(P[BASE + 0], P[BASE + 1]), a1 = cvtpk(P[BASE + 2], P[BASE + 3]);   \
    unsigned b0 = cvtpk(P[BASE + 4], P[BASE + 5]), b1 = cvtpk(P[BASE + 6], P[BASE + 7]);                              \
    auto r0 = __builtin_amdgcn_permlane32_swap(a0, b0, false, false); auto r1 = __builtin_amdgcn_permlane32_swap(a1, b1, false, false); \
    u32x4 w = {r0[0], r1[0], r0[1], r1[1]}; OUT = *reinterpret_cast<bf16x8*>(&w); } while (0)
  PK4(p0, 0, pa0); PK4(p0, 8, pa1); PK4(p1, 0, pa2); PK4(p1, 8, pa3);
#undef PK4
}
template <int DQK>
__device__ __forceinline__ void qkt(f32x16& p0, f32x16& p1, const bf16* Ks, const bf16x8* qr, int r32, int hi, int kcol) {
  p0 = f32x16{}; p1 = f32x16{};
#pragma unroll
  for (int d0 = 0; d0 < DQK / 16; ++d0) { int cb = (kcol + d0 * 16 + hi * 8) * 2;
    bf16x8 b0 = *reinterpret_cast<const bf16x8*>((const char*)Ks + KSWZ(r32, cb));
    bf16x8 b1 = *reinterpret_cast<const bf16x8*>((const char*)Ks + KSWZ(32 + r32, cb));
    p0 = __builtin_amdgcn_mfma_f32_32x32x16_bf16(b0, qr[d0], p0, 0, 0, 0);
    p1 = __builtin_amdgcn_mfma_f32_32x32x16_bf16(b1, qr[d0], p1, 0, 0, 0); }
}
__device__ __forceinline__ int v_st(int k, int c) { const int kk = (k & ~0xC) | ((k & 4) << 1) | ((k & 8) >> 1); return ((kk >> 3) * 4 + (c >> 5)) * 512 + ((kk & 7) * 32 + (c & 31)) * 2; }
__device__ __forceinline__ int v_rd_base(int lane) { return ((lane & 3) << 3) | (((lane >> 2) & 3) << 6) | (((lane >> 4) & 1) << 5) | (((lane >> 5) & 1) << 8); }
constexpr int v_rd_off(int d0, int ks, int half) { return d0 * 512 + ks * 4096 + half * 2048; }
template <int OFF> __device__ __forceinline__ s16x4 tr_read(int vb) {
  s16x4 r; asm volatile("ds_read_b64_tr_b16 %0, %1 offset:%2" : "=&v"(r) : "v"(vb), "i"(OFF) : "memory"); return r;
}
template <int D0> __device__ __forceinline__ void pv_one(f32x16& od, int vb, bf16x8 pa0, bf16x8 pa1, bf16x8 pa2, bf16x8 pa3) {
  const s16x4 l0 = tr_read<v_rd_off(D0, 0, 0)>(vb), h0 = tr_read<v_rd_off(D0, 0, 1)>(vb), l1 = tr_read<v_rd_off(D0, 1, 0)>(vb), h1 = tr_read<v_rd_off(D0, 1, 1)>(vb);
  const s16x4 l2 = tr_read<v_rd_off(D0, 2, 0)>(vb), h2 = tr_read<v_rd_off(D0, 2, 1)>(vb), l3 = tr_read<v_rd_off(D0, 3, 0)>(vb), h3 = tr_read<v_rd_off(D0, 3, 1)>(vb);
  asm volatile("s_waitcnt lgkmcnt(0)" ::: "memory"); SBAR();
#define PK(L, H) (bf16x8){L[0], L[1], L[2], L[3], H[0], H[1], H[2], H[3]}
  od = __builtin_amdgcn_mfma_f32_32x32x16_bf16(pa0, PK(l0, h0), od, 0, 0, 0);
  od = __builtin_amdgcn_mfma_f32_32x32x16_bf16(pa1, PK(l1, h1), od, 0, 0, 0);
  od = __builtin_amdgcn_mfma_f32_32x32x16_bf16(pa2, PK(l2, h2), od, 0, 0, 0);
  od = __builtin_amdgcn_mfma_f32_32x32x16_bf16(pa3, PK(l3, h3), od, 0, 0, 0);
#undef PK
}
__device__ __forceinline__ void pv_d0_exp(f32x16* o, int vb, bf16x8 pa0, bf16x8 pa1, bf16x8 pa2, bf16x8 pa3, f32x16& pe) {
  { const s16x4 l0 = tr_read<v_rd_off(0, 0, 0)>(vb), h0 = tr_read<v_rd_off(0, 0, 1)>(vb), l1 = tr_read<v_rd_off(0, 1, 0)>(vb), h1 = tr_read<v_rd_off(0, 1, 1)>(vb);
    const s16x4 l2 = tr_read<v_rd_off(0, 2, 0)>(vb), h2 = tr_read<v_rd_off(0, 2, 1)>(vb), l3 = tr_read<v_rd_off(0, 3, 0)>(vb), h3 = tr_read<v_rd_off(0, 3, 1)>(vb);
    SBAR(); expHalf(pe); SBAR();
    asm volatile("s_waitcnt lgkmcnt(0)" ::: "memory"); SBAR();
#define PK(L, H) (bf16x8){L[0], L[1], L[2], L[3], H[0], H[1], H[2], H[3]}
    o[0] = __builtin_amdgcn_mfma_f32_32x32x16_bf16(pa0, PK(l0, h0), o[0], 0, 0, 0);
    o[0] = __builtin_amdgcn_mfma_f32_32x32x16_bf16(pa1, PK(l1, h1), o[0], 0, 0, 0);
    o[0] = __builtin_amdgcn_mfma_f32_32x32x16_bf16(pa2, PK(l2, h2), o[0], 0, 0, 0);
    o[0] = __builtin_amdgcn_mfma_f32_32x32x16_bf16(pa3, PK(l3, h3), o[0], 0, 0, 0);
#undef PK
  }
  pv_one<1>(o[1], vb, pa0, pa1, pa2, pa3); pv_one<2>(o[2], vb, pa0, pa1, pa2, pa3); pv_one<3>(o[3], vb, pa0, pa1, pa2, pa3);
}
__device__ __forceinline__ void pv_d0(f32x16* o, int vb, bf16x8 pa0, bf16x8 pa1, bf16x8 pa2, bf16x8 pa3) {
  pv_one<0>(o[0], vb, pa0, pa1, pa2, pa3); pv_one<1>(o[1], vb, pa0, pa1, pa2, pa3); pv_one<2>(o[2], vb, pa0, pa1, pa2, pa3); pv_one<3>(o[3], vb, pa0, pa1, pa2, pa3);
}

template <int DQK, bool OF32, int LDP>
__device__ __forceinline__ void attn_unit(const bf16* __restrict__ Qb, const bf16* __restrict__ Kh, const bf16* __restrict__ Vh, void* __restrict__ Ob, int ldo, int seq, int kcol, char* lds) {
  int tid_ = threadIdx.x; asm volatile("" : "+v"(tid_));
  const int tid = tid_, wid = tid >> 6, lane = tid & 63, r32 = lane & 31, hi = lane >> 5;
  bf16* V_lds = (bf16*)lds; bf16* K_lds = (bf16*)(lds + 2 * SHM_V);
  float* ws = (float*)(lds + 2 * SHM_V + 2 * SHM_K) + wid * 64; float* li_l = ws;
  float l_reg = 0; f32x16 o[4] = {}; bf16x8 qr[DQK / 16];
  const bf16* Qw = Qb + (long)(wid * QBLK + r32) * LDP + hi * 8;
#pragma unroll
  for (int d0 = 0; d0 < DQK / 16; ++d0) qr[d0] = *reinterpret_cast<const bf16x8*>(Qw + d0 * 16);
  const int sr = tid >> 4, sc = (tid & 15) * 8, vst0 = v_st(sr, sc), vst1 = v_st(32 + sr, sc);
  const int vb0 = (int)(uintptr_t)V_lds + v_rd_base(lane);
  struct { bf16x8 vs0, vs1, ks0, ks1; } sr_[1];
#define SLOAD(i, k0) do { sr_[i].vs0 = *reinterpret_cast<const bf16x8*>(&Vh[(long)((k0) + sr) * LDP + sc]); sr_[i].vs1 = *reinterpret_cast<const bf16x8*>(&Vh[(long)((k0) + 32 + sr) * LDP + sc]); \
    sr_[i].ks0 = *reinterpret_cast<const bf16x8*>(&Kh[(long)((k0) + sr) * LDP + sc]); sr_[i].ks1 = *reinterpret_cast<const bf16x8*>(&Kh[(long)((k0) + 32 + sr) * LDP + sc]); } while (0)
#define SWRITE(b, i) do { *(bf16x8*)((char*)V_lds + (b) * SHM_V + vst0) = sr_[i].vs0;          \
    *(bf16x8*)((char*)V_lds + (b) * SHM_V + vst1) = sr_[i].vs1; int kc = sc * 2;               \
    *(bf16x8*)((char*)K_lds + (b) * SHM_K + KSWZ(sr, kc)) = sr_[i].ks0;                       \
    *(bf16x8*)((char*)K_lds + (b) * SHM_K + KSWZ(32 + sr, kc)) = sr_[i].ks1; } while (0)
#define SWAIT() asm volatile("s_waitcnt vmcnt(0)" ::: "memory")
  f32x16 pA0, pA1, pB0, pB1; bf16x8 pa0, pa1, pa2, pa3; const int NT = seq / KVBLK;
  constexpr int SE = 0, SO = 0;
  if (__builtin_amdgcn_readfirstlane(tid) >= 256) __builtin_amdgcn_s_setprio(1);
  SLOAD(SE, 0); asm volatile("s_waitcnt vmcnt(0)" ::: "memory"); SWRITE(0, SE); __syncthreads();
  qkt<DQK>(pA0, pA1, K_lds, qr, r32, hi, kcol); SBAR(); expHalf(pA0); SBAR();
  SLOAD(SO, KVBLK);
  SWAIT(); SWRITE(1, SO); __syncthreads();
  for (int j = 1; j + 1 < NT; j += 2) {
    SLOAD(SO, (j + 1) * KVBLK);
    SBAR(); qkt<DQK>(pB0, pB1, (bf16*)((char*)K_lds + SHM_K), qr, r32, hi, kcol);
    finishSM(pA0, pA1, l_reg, pa0, pa1, pa2, pa3); SBAR();
    pv_d0_exp(o, vb0, pa0, pa1, pa2, pa3, pB0); SBAR();
    __syncthreads(); SWAIT(); SWRITE(0, SE);
    __syncthreads();
    SLOAD(SE, (j + 2) * KVBLK);
    SBAR(); qkt<DQK>(pA0, pA1, K_lds, qr, r32, hi, kcol);
    finishSM(pB0, pB1, l_reg, pa0, pa1, pa2, pa3); SBAR();
    pv_d0_exp(o, vb0 + (int)SHM_V, pa0, pa1, pa2, pa3, pA0); SBAR();
    __syncthreads(); SWAIT(); SWRITE(1, SO);
    __syncthreads();
  }
  SBAR(); qkt<DQK>(pB0, pB1, (bf16*)((char*)K_lds + SHM_K), qr, r32, hi, kcol);
  finishSM(pA0, pA1, l_reg, pa0, pa1, pa2, pa3); SBAR();
  pv_d0_exp(o, vb0, pa0, pa1, pa2, pa3, pB0); SBAR();
  __syncthreads();
  finishSM(pB0, pB1, l_reg, pa0, pa1, pa2, pa3); SBAR();
  pv_d0(o, vb0 + (int)SHM_V, pa0, pa1, pa2, pa3);
  __builtin_amdgcn_s_setprio(0);
  { auto rr = __builtin_amdgcn_permlane32_swap(__float_as_uint(l_reg), __float_as_uint(l_reg), false, false); l_reg = __uint_as_float(rr[0]) + __uint_as_float(rr[1]); }
  if (hi == 0) li_l[r32] = l_reg; asm volatile("s_waitcnt lgkmcnt(0)" ::: "memory");
  float rli[16];
#pragma unroll
  for (int r = 0; r < 16; ++r) rli[r] = __builtin_amdgcn_rcpf(li_l[crow(r, hi)]);
  if constexpr (OF32) {
    float* Ow = (float*)Ob + (long)(wid * QBLK) * ldo;
#pragma unroll
    for (int r = 0; r < 16; ++r) { int orow = crow(r, hi);
      for (int d0 = 0; d0 < 4; ++d0) Ow[(long)orow * ldo + d0 * 32 + r32] = o[d0][r] * rli[r]; }
  } else {
    bf16* Ow = (bf16*)Ob + (long)(wid * QBLK) * ldo;
#pragma unroll
    for (int r = 0; r < 16; ++r) { int orow = crow(r, hi);
      for (int d0 = 0; d0 < 4; ++d0) Ow[(long)orow * ldo + d0 * 32 + r32] = __float2bfloat16(o[d0][r] * rli[r]); }
  }
  __syncthreads();
#undef SLOAD
#undef SWRITE
#undef SWAIT
}
#undef KSWZ
#undef SBAR
}
#ifndef REP_P0
#define REP_P0 1
#endif
#ifndef REP_K0
#define REP_K0 1
#endif
#ifndef REP_K2
#define REP_K2 1
#endif
#ifndef REP_K4
#define REP_K4 1
#endif
#ifndef REP_K5
#define REP_K5 1
#endif
#ifndef WIDE_MAX
#define WIDE_MAX 128
#endif
#ifndef REP_K7
#define REP_K7 1
#endif
#ifndef REP_K8
#define REP_K8 1
#endif
constexpr int NWAVES = 8, NTHREADS = 512;
constexpr int DM = 2048, NLAT = 8192, NCTX = 256, MR = NLAT + NCTX, DFF = 7168, NEXP = 8;
constexpr int PC = 3072;
constexpr int PC_QA = 0, PC_QB = 1024, PC_KA = 1536, PC_VA = 1792, PC_KB = 2048, PC_VB = 2560;
constexpr int WIN_ROWS = 4096;
constexpr int MOE_ROWS = 2 * NLAT + NEXP * 256;
constexpr float EPS = 1e-6f;
constexpr size_t MiB = 1u << 20;
constexpr size_t WS_CTL = 0, CTL_ZERO_BYTES = 1 * MiB;
constexpr size_t WS_MOD = 1 * MiB;
constexpr size_t WS_BF = WS_MOD + 256 * 1024;
constexpr size_t WS_TOK = 3 * MiB;
constexpr size_t WS_WGCNT = WS_TOK + 512 * 1024;
constexpr size_t WS_DFTC = 4 * MiB;
constexpr size_t WS_ZWTC = WS_DFTC + 512 * 1024;
constexpr size_t WS_WIN = 8 * MiB;
constexpr size_t WS_WOUT = 40 * MiB;
constexpr size_t WS_WGU = 56 * MiB;
constexpr size_t WS_WDN = 112 * MiB;
constexpr size_t WS_MGU = 140 * MiB;
constexpr size_t WS_MDN = 588 * MiB;
constexpr size_t WS_DFT = 812 * MiB;
constexpr size_t WS_X = 1068 * MiB;
constexpr size_t WS_H = 1134 * MiB;
constexpr size_t WS_O = 1167 * MiB;
constexpr size_t WS_P = 1200 * MiB;
constexpr size_t WS_ZWT = 1250 * MiB;
constexpr size_t WS_DIFFO = 1266 * MiB;
constexpr size_t WS_FP = 1299 * MiB;
constexpr size_t WS_Y = 1363 * MiB;
constexpr size_t WS_ACT = 1200 * MiB;
constexpr size_t WS_HS = 1200 * MiB;
constexpr size_t WS_DOUT = 1272 * MiB;
constexpr size_t WS_MACT = WS_DFT;
constexpr size_t WS_PART = 1344 * MiB;
constexpr size_t WS_END = 1412 * MiB;
constexpr int CW_TMO = 0, CW_BAR = 4096, CW_KMX = 8192, CW_TAIL = 9216;

constexpr int RING_BYTES = 131072, LDSCTL_OFF = RING_BYTES, MISC_OFF = LDSCTL_OFF + 12288, LDS_BYTES = 147456;

#define GAS __attribute__((address_space(1)))
#define LAS __attribute__((address_space(3)))
typedef unsigned short bf16_t;
typedef float f32x4 __attribute__((ext_vector_type(4)));
typedef unsigned u32x2 __attribute__((ext_vector_type(2)));
typedef unsigned u32x4 __attribute__((ext_vector_type(4)));

#define XB_TMO      128
#define XB_XCNT(j)  (256  + 64 * (j))
#define XB_XSUB(j)  (1280 + 64 * (j))
#define XB_XGEN(j)  (2304 + 64 * (j))
#define XB_TOP      3328
#define XB_TOPGEN   3392
#define XCD_BAR_WORDS 3456
#define XB_SPIN_CAP (1u << 18)
__device__ __forceinline__ unsigned xb_ld(unsigned* p)              { return __hip_atomic_load(p, __ATOMIC_RELAXED, __HIP_MEMORY_SCOPE_AGENT); }
__device__ __forceinline__ unsigned xb_add(unsigned* p, unsigned v) { return __hip_atomic_fetch_add(p, v, __ATOMIC_RELAXED, __HIP_MEMORY_SCOPE_AGENT); }
__device__ __forceinline__ unsigned xb_xcc_id() { return (unsigned)__builtin_amdgcn_s_getreg((3 << 11) | 20) & 0xFu; }
#define XB_SPIN(cond, bar) do { unsigned _sp = 0; while (cond) { __builtin_amdgcn_s_sleep(1); \
    if ((++_sp & 255u) == 0u) { if (xb_ld(&(bar)[XB_TMO])) break; if (_sp > XB_SPIN_CAP) { atomicAdd(&(bar)[XB_TMO], 1u); break; } } } } while (0)
struct XcdBarrier { unsigned* bar; unsigned x; volatile LAS unsigned* st; };
__device__ __forceinline__ XcdBarrier xcd_barrier_post(unsigned* bar, volatile LAS unsigned* st) {
    XcdBarrier b; b.bar = bar; b.x = xb_xcc_id(); b.st = st;
    if (threadIdx.x == 0) (void)xb_add(&bar[XB_XCNT(b.x)], 1u);
    return b;
}
__device__ __forceinline__ void xcd_barrier_complete(unsigned* bar, unsigned x, unsigned& nloc, unsigned& nx) {
    const unsigned G = gridDim.x * gridDim.y * gridDim.z;
    unsigned sum, cnt, mine, sp = 0u;
    for (;;) {
        sum = 0u; cnt = 0u; mine = 0u;
#pragma unroll
        for (unsigned j = 0; j < 16; ++j) { const unsigned c = xb_ld(&bar[XB_XCNT(j)]); sum += c; cnt += (c > 0u) ? 1u : 0u; mine = (j == x) ? c : mine; }
        if (sum == G) break;
        __builtin_amdgcn_s_sleep(1);
        if ((++sp & 255u) == 0u) { if (xb_ld(&bar[XB_TMO])) break; if (sp > XB_SPIN_CAP) { atomicAdd(&bar[XB_TMO], 1u); break; } }
    }
    nloc = mine > 0u ? mine : 1u; nx = cnt > 0u ? cnt : 1u;
}
__device__ __forceinline__ void xcd_barrier(const XcdBarrier& b) {
    asm volatile("s_waitcnt vmcnt(0)" ::: "memory");
    __syncthreads();
    if (threadIdx.x == 0) {
        unsigned* bar = b.bar; asm volatile("" : "+s"(bar));
        __builtin_amdgcn_s_waitcnt(0);
        unsigned nloc = b.st[0], nx = b.st[1];
        if (nloc == 0u) { xcd_barrier_complete(bar, b.x, nloc, nx); b.st[0] = nloc; b.st[1] = nx; }
        const unsigned old = xb_add(&bar[XB_XSUB(b.x)], 1u);
        const unsigned gen = old / nloc;
        if (old + 1u == (gen + 1u) * nloc) {
            __builtin_amdgcn_fence(__ATOMIC_RELEASE, "agent");
            asm volatile("s_waitcnt vmcnt(0)" ::: "memory");
            const unsigned og = xb_add(&bar[XB_TOP], 1u);
            const unsigned tg = og / nx;
            if (og + 1u == (tg + 1u) * nx) xb_add(&bar[XB_TOPGEN], 1u);
            else XB_SPIN(xb_ld(&bar[XB_TOPGEN]) == tg, bar);
            __builtin_amdgcn_fence(__ATOMIC_ACQUIRE, "agent");
            xb_add(&bar[XB_XGEN(b.x)], 1u);
            asm volatile("s_waitcnt vmcnt(0)" ::: "memory");
        } else {
            XB_SPIN(xb_ld(&bar[XB_XGEN(b.x)]) == gen, bar);
            __builtin_amdgcn_fence(__ATOMIC_ACQUIRE, "agent");
            asm volatile("s_waitcnt vmcnt(0)" ::: "memory");
        }
    }
    __syncthreads();
}

#define LDS_WAIT() asm volatile("s_waitcnt lgkmcnt(0)" ::: "memory")
__device__ __forceinline__ float wave_sum(float v) {
#pragma unroll
    for (int o = 1; o < 64; o <<= 1) v += __shfl_xor(v, o);
    return v;
}
__device__ __forceinline__ unsigned pk2(float lo, float hi) { return pg8::cvt_pk_bf16(lo, hi); }
__device__ __forceinline__ float bf_lo(unsigned u) { return __uint_as_float(u << 16); }
__device__ __forceinline__ float bf_hi(unsigned u) { return __uint_as_float(u & 0xffff0000u); }
__device__ __forceinline__ float silu_f(float v) { return v / (1.0f + __expf(-v)); }
__device__ __forceinline__ void ld_row_f32(const float* p, int lane, f32x4 (&v)[8]) {
    const f32x4* q = (const f32x4*)p + lane;
#pragma unroll
    for (int j = 0; j < 8; ++j) v[j] = q[64 * j];
}
__device__ __forceinline__ void ld_row_bf16(const bf16_t* p, int lane, f32x4 (&v)[8]) {
    const u32x2* q = (const u32x2*)p + lane;
#pragma unroll
    for (int j = 0; j < 8; ++j) { const u32x2 w = q[64 * j]; v[j] = (f32x4){bf_lo(w.x), bf_hi(w.x), bf_lo(w.y), bf_hi(w.y)}; }
}
__device__ __forceinline__ void st_row_bf16(bf16_t* p, int lane, const f32x4 (&v)[8]) {
    u32x2* q = (u32x2*)p + lane;
#pragma unroll
    for (int j = 0; j < 8; ++j) { u32x2 w; w.x = pk2(v[j].x, v[j].y); w.y = pk2(v[j].z, v[j].w); q[64 * j] = w; }
}
__device__ __forceinline__ void st_row_f32(float* p, int lane, const f32x4 (&v)[8]) {
    f32x4* q = (f32x4*)p + lane;
#pragma unroll
    for (int j = 0; j < 8; ++j) q[64 * j] = v[j];
}
__device__ __forceinline__ void ld_row_f32_nt(const float* p, int lane, f32x4 (&v)[8]) {
    const f32x4* q = (const f32x4*)p + lane;
#pragma unroll
    for (int j = 0; j < 8; ++j) v[j] = __builtin_nontemporal_load(q + 64 * j);
}
__device__ __forceinline__ void st_row_f32_nt(float* p, int lane, const f32x4 (&v)[8]) {
    f32x4* q = (f32x4*)p + lane;
#pragma unroll
    for (int j = 0; j < 8; ++j) __builtin_nontemporal_store(v[j], q + 64 * j);
}
__device__ __forceinline__ float row_sumsq(const f32x4 (&v)[8]) {
    float s = 0.f;
#pragma unroll
    for (int j = 0; j < 8; ++j) s += (v[j].x * v[j].x + v[j].y * v[j].y) + (v[j].z * v[j].z + v[j].w * v[j].w);
    return wave_sum(s);
}

__device__ __forceinline__ void transpose_item(const float* __restrict__ src, size_t ld, int k0, int c0, bf16_t* __restrict__ dst, size_t ldd, int r0, LAS float* scr, int lane) {
    const int lr = lane >> 3, lc = (lane & 7) * 4;
    f32x4 t[8];
#pragma unroll
    for (int i = 0; i < 8; ++i) t[i] = __builtin_nontemporal_load((const f32x4*)(src + (size_t)(k0 + 8 * i + lr) * ld + c0 + lc));
#pragma unroll
    for (int i = 0; i < 8; ++i) { LAS float* s = scr + (8 * i + lr) * 33 + lc; s[0] = t[i].x; s[1] = t[i].y; s[2] = t[i].z; s[3] = t[i].w; }
    LDS_WAIT(); asm volatile("" ::: "memory");
    const int c = lane & 7;
#pragma unroll
    for (int j = 0; j < 4; ++j) { const int n = (lane >> 3) + 8 * j; const LAS float* s = scr + (8 * c) * 33 + n;
        u32x4 o; o.x = pk2(s[0 * 33], s[1 * 33]); o.y = pk2(s[2 * 33], s[3 * 33]); o.z = pk2(s[4 * 33], s[5 * 33]); o.w = pk2(s[6 * 33], s[7 * 33]);
        __builtin_nontemporal_store(o, (u32x4*)(dst + (size_t)(r0 + n) * ldd + k0 + 8 * c)); }
    LDS_WAIT(); asm volatile("" ::: "memory");
}
__device__ __forceinline__ void transpose_item64(const float* __restrict__ src, size_t ld, int k0, int c0, bf16_t* __restrict__ dst, size_t ldd, int r0, LAS float* scr, int lane) {
    const int lr = lane >> 4, lc = (lane & 15) * 4;
    f32x4 t[16];
#pragma unroll
    for (int i = 0; i < 16; ++i) t[i] = __builtin_nontemporal_load((const f32x4*)(src + (size_t)(k0 + 4 * i + lr) * ld + c0 + lc));
#pragma unroll
    for (int i = 0; i < 16; ++i) { LAS float* s = scr + (4 * i + lr) * 65 + lc; s[0] = t[i].x; s[1] = t[i].y; s[2] = t[i].z; s[3] = t[i].w; }
    LDS_WAIT(); asm volatile("" ::: "memory");
    const int c = lane & 7;
#pragma unroll
    for (int j = 0; j < 8; ++j) { const int n = (lane >> 3) + 8 * j; const LAS float* s = scr + (8 * c) * 65 + n;
        u32x4 o; o.x = pk2(s[0 * 65], s[1 * 65]); o.y = pk2(s[2 * 65], s[3 * 65]); o.z = pk2(s[4 * 65], s[5 * 65]); o.w = pk2(s[6 * 65], s[7 * 65]);
        __builtin_nontemporal_store(o, (u32x4*)(dst + (size_t)(r0 + n) * ldd + k0 + 8 * c)); }
    LDS_WAIT(); asm volatile("" ::: "memory");
}
struct Args { const float* in[27]; float* out; unsigned char* ws; int ph_lo, ph_hi; };
__device__ __forceinline__ const float* inptr(const Args& a, int k) { asm volatile("" : "+s"(k)); return a.in[k]; }
__device__ __forceinline__ unsigned char* wsptr(const Args& a, size_t off) { unsigned char* p = a.ws; asm volatile("" : "+s"(p)); return p + off; }

__device__ __forceinline__ const float* modp(const unsigned char* ws, int l, int v, int chunk) { return (const float*)(ws + WS_MOD) + ((size_t)(l * 2 + v) * 6 + chunk) * DM; }

__device__ __forceinline__ void moe_tables(const unsigned char* ws, LAS unsigned char* ldsctl, LAS unsigned char* tmp, bool want_base, int G) {
    LAS int* T = (LAS int*)ldsctl; LAS int* W = (LAS int*)tmp;
    const int* wg = (const int*)(ws + WS_WGCNT);
    int tid = threadIdx.x; asm volatile("" : "+v"(tid));
    __syncthreads();
    for (int i = tid; i < G * 8; i += NTHREADS) W[i] = wg[i];
    __syncthreads();
    const int wv_ = __builtin_amdgcn_readfirstlane(tid >> 6), ln_ = tid & 63;
    const int per_ = (G + 63) >> 6;
    int ls_ = 0;
    for (int k = 0; k < per_; ++k) { const int w = ln_ * per_ + k; if (w < G) ls_ += W[w * 8 + wv_]; }
    int inc_ = ls_;
#pragma unroll
    for (int d = 1; d < 64; d <<= 1) { const int o_ = __shfl_up(inc_, d); if (ln_ >= d) inc_ += o_; }
    if (ln_ == 63) T[16 + wv_] = inc_;
    __syncthreads();
    if (tid == 0) { int o = 0; for (int e = 0; e < 8; ++e) { T[e] = o; o += ((T[16 + e] + 255) >> 8) << 8; } T[8] = o; T[32] = o >> 8; }
    __syncthreads();
    if (tid < 72) { const int r = tid * 256; int e = 0;
#pragma unroll
        for (int jj = 1; jj < 8; ++jj) e += (T[jj] <= r) ? 1 : 0;
        T[64 + tid] = e; }
    if (want_base) { int s = T[wv_] + inc_ - ls_;
        for (int k = 0; k < per_; ++k) { const int w = ln_ * per_ + k; if (w < G) { T[256 + w * 8 + wv_] = s; s += W[w * 8 + wv_]; } } }
    __syncthreads();
}

constexpr int J_GU = 32 * 448, J_DN = 112 * 64, J_FFN = J_GU + J_DN;
__device__ __forceinline__ void ffn_weight_item(int e, int r, const float* w_gate_d, const float* w_up_d, const float* w_down_d, const float* w_gate_m, const float* w_up_m, const float* w_down_m,
                                                bf16_t* WGU, bf16_t* WDN, bf16_t* MGU, bf16_t* MDN, LAS float* scr, int lane) {
    if (r < J_GU) { const int kb = r / 448, nb = r % 448; const int n0 = nb * 32; const int tile = n0 >> 8, half = (n0 >> 7) & 1, j0 = n0 & 127;
        const float* src = e == 0 ? (half ? w_up_d : w_gate_d) : (half ? w_up_m : w_gate_m) + (size_t)(e - 1) * DM * DFF;
        bf16_t* dst = e == 0 ? WGU : MGU + (size_t)(e - 1) * 2 * DFF * DM;
        transpose_item(src, DFF, kb * 64, tile * 128 + j0, dst, DM, n0, scr, lane); }
    else { r -= J_GU; const int kb = r / 64, nb = r % 64;
        const float* src = e == 0 ? w_down_d : w_down_m + (size_t)(e - 1) * DFF * DM;
        bf16_t* dst = e == 0 ? WDN : MDN + (size_t)(e - 1) * DM * DFF;
        transpose_item(src, DM, kb * 64, nb * 32, dst, DFF, nb * 32, scr, lane); }
}

__global__ void __launch_bounds__(NTHREADS, 2) fwd_kernel(Args args) {
    extern __shared__ __attribute__((aligned(16))) unsigned char lds[];
    LAS unsigned char* L = (LAS unsigned char*)lds;
    volatile LAS unsigned* MISC = (volatile LAS unsigned*)(L + MISC_OFF);
    const int tid0 = threadIdx.x;
    const int G = gridDim.x, bx = blockIdx.x;
    const int vcu = (G % 8 == 0) ? (bx % 8) * (G / 8) + bx / 8 : bx;
    const int NGW = G * NWAVES;
#define PHASE_LOCALS int tid = tid0; asm volatile("" : "+v"(tid)); const int lane = tid & 63, wave = __builtin_amdgcn_readfirstlane(tid >> 6), gw = vcu * NWAVES + wave; (void)lane; (void)wave; (void)gw;
    unsigned char* ws = args.ws;
    unsigned* ctl = (unsigned*)(ws + WS_CTL);
    for (int u = tid0; u < (LDS_BYTES - LDSCTL_OFF) / 4; u += NTHREADS) ((LAS unsigned*)(L + LDSCTL_OFF))[u] = 0u;
    __syncthreads();
    XcdBarrier bar = xcd_barrier_post(ctl + CW_BAR, MISC + 8);
    const int lo = args.ph_lo, hi = args.ph_hi;
#define IN(k) (lo <= (k) && (k) < hi)
#define SEAM(k) do { if (IN(k) && IN((k) + 1)) xcd_barrier(bar); } while (0)

    const float* x_in = args.in[0]; const float* c_in = args.in[1]; const float* ctx_in = args.in[2]; const float* cctx_in = args.in[3];
    const float* w_mod = args.in[4]; const float* b_mod = args.in[5];
    const float* g_pre_mix = args.in[6]; const float* g_post_mix = args.in[7]; const float* g_pre_ffn = args.in[8]; const float* g_post_ffn = args.in[9];
    const float* w_in = args.in[10]; const float* g_q_a = args.in[11]; const float* g_k_a = args.in[12];
    const float* lq1 = args.in[13]; const float* lk1 = args.in[14]; const float* lq2 = args.in[15]; const float* lk2 = args.in[16];
    const float* g_subln = args.in[17]; const float* w_fourier = args.in[18]; const float* w_out = args.in[19];
    const float* w_gate_d = args.in[20]; const float* w_up_d = args.in[21]; const float* w_down_d = args.in[22]; const float* w_router = args.in[23];
    const float* w_gate_m = args.in[24]; const float* w_up_m = args.in[25]; const float* w_down_m = args.in[26];
    bf16_t* WIN = (bf16_t*)(ws + WS_WIN); bf16_t* WOUT = (bf16_t*)(ws + WS_WOUT); bf16_t* WGU = (bf16_t*)(ws + WS_WGU); bf16_t* WDN = (bf16_t*)(ws + WS_WDN);
    bf16_t* MGU = (bf16_t*)(ws + WS_MGU); bf16_t* MDN = (bf16_t*)(ws + WS_MDN); bf16_t* DFT = (bf16_t*)(ws + WS_DFT); bf16_t* DFTC = (bf16_t*)(ws + WS_DFTC);
    float* X = (float*)(ws + WS_X); bf16_t* H = (bf16_t*)(ws + WS_H); bf16_t* O = (bf16_t*)(ws + WS_O); bf16_t* P = (bf16_t*)(ws + WS_P);
    bf16_t* ZWT = (bf16_t*)(ws + WS_ZWT); bf16_t* ZWTC = (bf16_t*)(ws + WS_ZWTC); bf16_t* DIFFO = (bf16_t*)(ws + WS_DIFFO); bf16_t* Y1 = (bf16_t*)(ws + WS_FP);
    bf16_t* Y = (bf16_t*)(ws + WS_Y); bf16_t* ACT = (bf16_t*)(ws + WS_ACT); bf16_t* HS = (bf16_t*)(ws + WS_HS); bf16_t* DOUT = (bf16_t*)(ws + WS_DOUT); bf16_t* MACT = (bf16_t*)(ws + WS_MACT);
    float* BF = (float*)(ws + WS_BF); unsigned* TOK = (unsigned*)(ws + WS_TOK); int* WGCNT = (int*)(ws + WS_WGCNT);

    if (IN(0)) for (int rep_ = 0; rep_ < REP_P0; ++rep_) {
        PHASE_LOCALS
        {
            LAS float* sl = (LAS float*)L; LAS float* scx = sl + DM; LAS float* red = scx + DM;
            __syncthreads();
            for (int k = tid; k < DM; k += NTHREADS) { sl[k] = silu_f(c_in[k]); scx[k] = silu_f(cctx_in[k]); }
            __syncthreads();
            for (int job = vcu; job < 256; job += G) {
                const int l = job >> 7, cg = job & 127;
                const float* wm = w_mod + (size_t)l * DM * 12288 + cg * 96;
                const int c4 = tid % 24, rg = tid / 24;
                f32x4 al = {0.f, 0.f, 0.f, 0.f}, ac = {0.f, 0.f, 0.f, 0.f};
                if (rg < 21) {
#pragma unroll 14
                    for (int k = rg; k < DM; k += 21) { const f32x4 w = __builtin_nontemporal_load((const f32x4*)(wm + (size_t)k * 12288 + c4 * 4));     const float a = sl[k], b = scx[k]; al += w * a; ac += w * b; }
                    LAS float* r = red + (rg * 24 + c4) * 8; r[0] = al.x; r[1] = al.y; r[2] = al.z; r[3] = al.w; r[4] = ac.x; r[5] = ac.y; r[6] = ac.z; r[7] = ac.w;
                }
                __syncthreads();
                if (tid < 192) { const int v = tid / 96, col = tid % 96; float s = 0.f; for (int r = 0; r < 21; ++r) s += red[(r * 24 + (col >> 2)) * 8 + v * 4 + (col & 3)];
                    ((float*)(ws + WS_MOD))[(size_t)(l * 2 + v) * 12288 + cg * 96 + col] = s + b_mod[(size_t)l * 12288 + cg * 96 + col]; }
                __syncthreads();
            }
        }
        for (int job = vcu; job < 16; job += G) {
            const int l = job >> 3, part = (job >> 2) & 1, g = job & 3;
            LAS float* Wl = (LAS float*)L; LAS float* tb = Wl + 128 * 128;
            const float* W = w_fourier + (size_t)(l * 4 + g) * 128 * 128;
            for (int i = tid; i < 128 * 128; i += NTHREADS) Wl[i] = W[i];
            if (tid < 128) { const float ph = (float)tid * (1.0f / 128.0f); tb[tid] = (part ? -__builtin_amdgcn_sinf(ph) : __builtin_amdgcn_cosf(ph)) * 0.08838834764831845f; }
            __syncthreads();
            const int d4 = tid & 31, cg = tid >> 5;
            f32x4 acc[8];
#pragma unroll
            for (int i = 0; i < 8; ++i) acc[i] = (f32x4){0.f, 0.f, 0.f, 0.f};
#pragma unroll 2
            for (int lp = 0; lp < 128; ++lp) { const f32x4 wv = *(const LAS f32x4*)(Wl + lp * 128 + 4 * d4);
#pragma unroll
                for (int i = 0; i < 8; ++i) acc[i] += wv * tb[(lp * (cg * 8 + i)) & 127]; }
            float* out = BF + ((size_t)((l * 2 + part) * 4 + g) * 128) * 128;
#pragma unroll
            for (int i = 0; i < 8; ++i) *(f32x4*)(out + (size_t)(cg * 8 + i) * 128 + 4 * d4) = acc[i];
            __syncthreads();
        }
        {
            const int gt = vcu * NTHREADS + tid, NT = G * NTHREADS;
            for (int i = gt; i < 1024 * 128; i += NT) { const int m = i >> 7, c8 = (i & 127) * 8; const int ro = m >> 9, k1 = m & 511, part = c8 >> 9, n1 = c8 & 511;
                float v[8];
#pragma unroll
                for (int j = 0; j < 8; ++j) { const float ph = (float)((k1 * (n1 + j)) & 511) * (1.0f / 512.0f); const float cs = __builtin_amdgcn_cosf(ph), sn = __builtin_amdgcn_sinf(ph);
                    v[j] = (ro == 0 ? (part == 0 ? cs : sn) : (part == 0 ? -sn : cs)) * 0.011048543456039806f; }
                u32x4 o; o.x = pk2(v[0], v[1]); o.y = pk2(v[2], v[3]); o.z = pk2(v[4], v[5]); o.w = pk2(v[6], v[7]);
                *(u32x4*)(DFT + (size_t)i * 8) = o; }
            for (int i = gt; i < NCTX * 64; i += NT) { const int k = i >> 6, n8 = (i & 63) * 8; const int part = n8 >= NCTX; const int n = n8 & (NCTX - 1);
                float v[8];
#pragma unroll
                for (int j = 0; j < 8; ++j) { const float ph = (float)((k * (n + j)) & (NCTX - 1)) * (1.0f / NCTX); v[j] = (part ? __builtin_amdgcn_sinf(ph) : __builtin_amdgcn_cosf(ph)) * 0.0625f; }
                u32x4 o; o.x = pk2(v[0], v[1]); o.y = pk2(v[2], v[3]); o.z = pk2(v[4], v[5]); o.w = pk2(v[6], v[7]);
                *(u32x4*)(DFTC + (size_t)i * 8) = o; }
        }
        {
            LAS float* scr = (LAS float*)(L + wave * 16640);
            constexpr int I_IN = 32 * 96, I_OUT = 32 * 64;
            constexpr int NITEMS = 2 * I_IN + 2 * I_OUT;
            for (int it = gw; it < NITEMS; it += NGW) {
                int r = it;
                if (r < 2 * I_IN) { const int l = r / I_IN; r %= I_IN; const int kb = r / 96, nb = r % 96; const int n0 = nb * 32; const int c0 = n0 < 1536 ? n0 : n0 + 512;
                    transpose_item(w_in + (size_t)l * DM * 3584, 3584, kb * 64, c0, WIN + (size_t)l * WIN_ROWS * DM, DM, n0, scr, lane); continue; }
                r -= 2 * I_IN;
                { const int l = r / I_OUT; r %= I_OUT; const int kb = r / 64, nb = r % 64;
                    transpose_item(w_out + (size_t)l * DM * DM, DM, kb * 64, nb * 32, WOUT + (size_t)l * DM * DM, DM, nb * 32, scr, lane); }
            }
            { LAS float* scr64 = (LAS float*)(L + wave * 16640); const int npro = (G % 2 == 0) ? 1 : 9;
              for (int it = gw; it < npro * J_FFN; it += NGW) ffn_weight_item(it / J_FFN, it % J_FFN, w_gate_d, w_up_d, w_down_d, w_gate_m, w_up_m, w_down_m, WGU, WDN, MGU, MDN, scr64, lane); }
        }
    }
    SEAM(0);

    if (IN(1)) {
        PHASE_LOCALS
        for (int job = vcu; job < 512; job += G) {
            const int l = job >> 8, g = (job >> 6) & 3, part = (job >> 5) & 1, kb = job & 31;
            LAS float* Wc = (LAS float*)L; LAS float* Bp = Wc + 64 * 128;
            __syncthreads();
            for (int i = tid; i < 64 * 32; i += NTHREADS) { const int row = i >> 5, c4 = (i & 31) * 4; *(LAS f32x4*)(Wc + row * 128 + c4) = *(const f32x4*)(w_in + ((size_t)l * DM + kb * 64 + row) * 3584 + 1536 + g * 128 + c4); }
            const float* bsrc = BF + ((size_t)((l * 2 + part) * 4 + g) * 128) * 128;
            for (int i = tid; i < 128 * 32; i += NTHREADS) *(LAS f32x4*)(Bp + i * 4) = *(const f32x4*)(bsrc + i * 4);
            __syncthreads();
            const int d4 = tid & 31, kg = tid >> 5;
            f32x4 acc[4];
#pragma unroll
            for (int i = 0; i < 4; ++i) acc[i] = (f32x4){0.f, 0.f, 0.f, 0.f};
#pragma unroll 4
            for (int c = 0; c < 128; ++c) { const f32x4 bv = *(const LAS f32x4*)(Bp + c * 128 + 4 * d4);
#pragma unroll
                for (int i = 0; i < 4; ++i) acc[i] += bv * Wc[(4 * kg + i) * 128 + c]; }
#pragma unroll
            for (int e = 0; e < 4; ++e) { u32x2 o; o.x = pk2(acc[0][e], acc[1][e]); o.y = pk2(acc[2][e], acc[3][e]);
                *(u32x2*)(WIN + (size_t)l * WIN_ROWS * DM + (size_t)(3072 + part * 512 + g * 128 + 4 * d4 + e) * DM + kb * 64 + 4 * kg) = o; }
        }
        __syncthreads();
        LAS float* va = (LAS float*)L;
        for (int i = tid; i < 2 * DM; i += NTHREADS) { const int v = i >> 11, c = i & (DM - 1); va[(v * 2 + 0) * DM + c] = g_pre_mix[c] * (1.0f + modp(ws, 0, v, 1)[c]); va[(v * 2 + 1) * DM + c] = modp(ws, 0, v, 0)[c]; }
        __syncthreads();
        for (int row = gw; row < MR; row += NGW) {
            const int v = row >= NLAT; const float* src = v ? ctx_in + (size_t)(row - NLAT) * DM : x_in + (size_t)row * DM;
            f32x4 xv[8]; ld_row_f32_nt(src, lane, xv);
            const float r = __builtin_amdgcn_rsqf(row_sumsq(xv) * (1.0f / DM) + EPS);
            const LAS f32x4* A = (const LAS f32x4*)(va + (v * 2) * DM) + lane; const LAS f32x4* B = (const LAS f32x4*)(va + (v * 2 + 1) * DM) + lane;
#pragma unroll
            for (int j = 0; j < 8; ++j) xv[j] = xv[j] * r * A[64 * j] + B[64 * j];
            st_row_bf16(H + (size_t)row * DM, lane, xv);
        }
    }
    SEAM(1);
    for (int l = 0; l < 2; ++l) {
        const int PB = 2 + l * 10;
        bf16_t* WINl = WIN + (size_t)l * WIN_ROWS * DM; bf16_t* WOUTl = WOUT + (size_t)l * DM * DM;
        const int nrows = l == 0 ? MR : NLAT;
        const float lambda_init = l == 0 ? 0.2f : 0.35550906759096927f;

        if (IN(PB + 0)) for (int rep_ = 0; rep_ < REP_K0; ++rep_) {
#ifndef NO_G0
            { pg8::Gemm g{H, WINl, DM, DM, DM}; pg8::SchedIn S{G, bx, 0, 0};
              pg8::EpiBf16 E{P, PC, P, PC};
              pg8::gemm_phase<pg8::EpiBf16, pg8::SchedIn, true>(L, g, S, E); }
#endif
#ifndef NO_G1
            { pg8::Gemm g{WINl + (size_t)3072 * DM, H, DM, 16 * DM, DM}; pg8::SchedZW S{G, (bx + G / 2) % G};
              pg8::EpiBf16 E{ZWT, 16384, ZWTC, 512};
              pg8::gemm_phase<pg8::EpiBf16, pg8::SchedZW, true>(L, g, S, E); }
#endif
            { PHASE_LOCALS
              const bf16_t* Hc = H + (size_t)NLAT * DM; bf16_t* Pc = P + (size_t)NLAT * PC;
              if (l == 0) {
                            pg8::ctx_gemm<0>(Hc, DM, WINl, DM, DM, 48, 0, Pc, PC, 0, L, tid, vcu, G);
                            pg8::ctx_gemm<2>(Hc, DM, WINl, DM, DM, 16, 3072, ZWTC, 512, 0, L, tid, (vcu + 64) % G, G);
              } else {
                            pg8::ctx_gemm<0>(Hc, DM, WINl, DM, DM, 24, 1536, Pc, PC, 1536, L, tid, vcu, G);
              }
            }
        }
        SEAM(PB + 0);

        if (IN(PB + 1)) {
            PHASE_LOCALS
            const int sub = lane >> 3, t = lane & 7;
            for (int row = gw; row < MR; row += NGW) {
                const bool is_lat = row < NLAT; const int prow = row >> 6, pcol = row & 63;
                bf16_t* pr = P + (size_t)row * PC;
#pragma unroll 1
                for (int pass = 0; pass < 3; ++pass) {
                    const int seg = pass * 8 + sub;
                    if (seg >= 18) continue;
                    if (l == 1 && !is_lat && seg < 12) continue;
                    const bool typeA = seg < 8 || (seg >= 12 && seg < 14), isq = seg < 12;
                    const int col0 = seg < 8 ? PC_QA + seg * 128 : seg < 12 ? PC_QB + (seg - 8) * 128 : seg < 14 ? PC_KA + (seg - 12) * 128 : PC_KB + (seg - 14) * 128;
                    int cA_, cB_, jb; bool is_col; float fmul;
                    if (typeA) { cA_ = t < 4 ? t : t + 4; cB_ = cA_ + 4; jb = (t & 3) * 8; is_col = t >= 4; fmul = -0.41524101186092029f; }
                    else { const int v = t >> 2, tt = t & 3; const int cc = tt < 2 ? tt : tt + 2; cA_ = v * 8 + cc; cB_ = cA_ + 2; jb = (tt & 1) * 8; is_col = tt >= 2; fmul = -0.83048202372184059f; }
                    u32x4 wa = *(const u32x4*)(pr + col0 + cA_ * 8), wb = *(const u32x4*)(pr + col0 + cB_ * 8);
                    float xa[8], xb[8];
                    xa[0] = bf_lo(wa.x); xa[1] = bf_hi(wa.x); xa[2] = bf_lo(wa.y); xa[3] = bf_hi(wa.y); xa[4] = bf_lo(wa.z); xa[5] = bf_hi(wa.z); xa[6] = bf_lo(wa.w); xa[7] = bf_hi(wa.w);
                    xb[0] = bf_lo(wb.x); xb[1] = bf_hi(wb.x); xb[2] = bf_lo(wb.y); xb[3] = bf_hi(wb.y); xb[4] = bf_lo(wb.z); xb[5] = bf_hi(wb.z); xb[6] = bf_lo(wb.w); xb[7] = bf_hi(wb.w);
                    if (typeA) {
                        float ss = 0.f;
#pragma unroll
                        for (int i = 0; i < 8; ++i) ss += xa[i] * xa[i] + xb[i] * xb[i];
                        ss += __shfl_xor(ss, 1); ss += __shfl_xor(ss, 2); ss += __shfl_xor(ss, 4);
                        const float r = __builtin_amdgcn_rsqf(ss * (1.0f / 128.0f) + EPS);
                        const float* gv = (seg < 8 ? g_q_a : g_k_a) + l * 128;
#pragma unroll
                        for (int i = 0; i < 8; ++i) { xa[i] *= r * gv[cA_ * 8 + i]; xb[i] *= r * gv[cB_ * 8 + i]; }
                    }
                    if (is_lat) {
                        const float pos = (float)(is_col ? pcol : prow);
#pragma unroll
                        for (int i = 0; i < 8; ++i) { const float fr = __builtin_amdgcn_exp2f((float)(jb + i) * fmul); const float rev = pos * fr * 0.15915494309189535f;
                            const float cs = __builtin_amdgcn_cosf(rev), sn = __builtin_amdgcn_sinf(rev); const float a = xa[i], b = xb[i]; xa[i] = a * cs - b * sn; xb[i] = b * cs + a * sn; }
                    }
                    if (isq) { const float cq = typeA ? 0.12751743082459868f : 0.18033688011112042f;
#pragma unroll
                        for (int i = 0; i < 8; ++i) { xa[i] *= cq; xb[i] *= cq; } }
                    wa.x = pk2(xa[0], xa[1]); wa.y = pk2(xa[2], xa[3]); wa.z = pk2(xa[4], xa[5]); wa.w = pk2(xa[6], xa[7]);
                    wb.x = pk2(xb[0], xb[1]); wb.y = pk2(xb[2], xb[3]); wb.z = pk2(xb[4], xb[5]); wb.w = pk2(xb[6], xb[7]);
                    if (isq || typeA || is_lat) { *(u32x4*)(pr + col0 + cA_ * 8) = wa; *(u32x4*)(pr + col0 + cB_ * 8) = wb; }
                }
            }
        }
        SEAM(PB + 1);

        if (IN(PB + 2)) for (int rep_ = 0; rep_ < REP_K2; ++rep_) {
            PHASE_LOCALS
            const int nctxu = l == 0 ? 8 : 0;
#define MOE_CONVERT() do { if (G % 2 == 0) { LAS float* scr_ = (LAS float*)(L + wave * 16640); \
          \
        const int ib_ = (1 + 4 * l) * J_FFN, ie_ = (5 + 4 * l) * J_FFN; const bool skew_ = G == 256; const int nall_ = skew_ ? 37 : (4 * J_FFN + NGW - 1) / NGW, nown_ = nall_ + ((skew_ && bx < 128) ? 10 : 0); \
        for (int r_ = 0; r_ < nown_; ++r_) { const int it_ = ib_ + (r_ < nall_ ? r_ * NGW + gw : nall_ * NGW + (r_ - nall_) * (NGW / 2) + bx * NWAVES + wave); if (it_ >= ie_) break; \
            ffn_weight_item(it_ / J_FFN, it_ % J_FFN, w_gate_d, w_up_d, w_down_d, w_gate_m, w_up_m, w_down_m, WGU, WDN, MGU, MDN, scr_, lane); } \
        __syncthreads(); } } while (0)
            if (vcu % 3 == 0) MOE_CONVERT();
#ifndef NO_ATTA
            for (int U = vcu; U < 256 + nctxu; U += G) {
                const bool isc = U >= 256; const int head = isc ? U - 256 : U >> 5, qrow = isc ? NLAT : (U & 31) * 256, krow = isc ? NLAT : 0, seq = isc ? NCTX : MR;
                att::attn_unit<128, false, PC>((const att::bf16*)(P + (size_t)qrow * PC + PC_QA + head * 128), (const att::bf16*)(P + (size_t)krow * PC + PC_KA + (head >> 2) * 128),
                    (const att::bf16*)(P + (size_t)krow * PC + PC_VA + (head >> 2) * 128), (void*)(Y + (size_t)qrow * DM + head * 128), DM, seq, 0, (char*)lds);
            }
#endif
            if (vcu % 3 == 1) MOE_CONVERT();
#ifndef NO_ATTB
            for (int U = vcu; U < 256 + nctxu; U += G) {
                const bool isc = U >= 256; const int hc = isc ? U - 256 : U >> 5, head = hc >> 1, comp = hc & 1, qrow = isc ? NLAT : (U & 31) * 256, krow = isc ? NLAT : 0, seq = isc ? NCTX : MR;
                att::attn_unit<64, false, PC>((const att::bf16*)(P + (size_t)qrow * PC + PC_QB + head * 128 + comp * 64), (const att::bf16*)(P + (size_t)krow * PC + PC_KB + head * 128),
                    (const att::bf16*)(P + (size_t)krow * PC + PC_VB + head * 128), (void*)(DIFFO + (size_t)comp * MR * 512 + (size_t)qrow * 512 + head * 128), 512, seq, comp * 64, (char*)lds);
            }
#endif
            if (vcu % 3 == 2) MOE_CONVERT();
#undef MOE_CONVERT
#ifndef NO_GEMM
            { pg8::Gemm g{DFT, ZWT, 1024, 16384, 1024}; pg8::SchedF1 S{G, (bx + G / 2) % G};
              pg8::EpiBf16 E{Y1, 512, Y1, 512};
              pg8::gemm_phase<pg8::EpiBf16, pg8::SchedF1, true>(L, g, S, E); }
#endif
        }
        SEAM(PB + 2);

        if (IN(PB + 3)) {
            PHASE_LOCALS
            const float lam = __expf(wave_sum(lq1[l * 64 + lane] * lk1[l * 64 + lane])) - __expf(wave_sum(lq2[l * 64 + lane] * lk2[l * 64 + lane])) + lambda_init;
            const float g0 = g_subln[l * 128 + 2 * lane] * (1.0f - lambda_init), g1 = g_subln[l * 128 + 2 * lane + 1] * (1.0f - lambda_init);
            for (int row = gw; row < nrows; row += NGW) {
#pragma unroll
                for (int h = 0; h < 4; ++h) {
                    const unsigned u1_ = *(const unsigned*)(DIFFO + (size_t)row * 512 + h * 128 + 2 * lane), u2_ = *(const unsigned*)(DIFFO + (size_t)MR * 512 + (size_t)row * 512 + h * 128 + 2 * lane);
                    const float2 o1 = {bf_lo(u1_), bf_hi(u1_)}, o2 = {bf_lo(u2_), bf_hi(u2_)};
                    const float d0 = o1.x - lam * o2.x, d1 = o1.y - lam * o2.y;
                    const float r = __builtin_amdgcn_rsqf(wave_sum(d0 * d0 + d1 * d1) * (1.0f / 128.0f) + EPS);
                    *(unsigned*)(Y + (size_t)row * DM + 1024 + h * 128 + 2 * lane) = pk2(d0 * r * g0, d1 * r * g1);
                }
            }
            for (int item = gw; item < 2048; item += NGW) {
                const int k1 = item >> 2, qf = item & 3;
                f32x4 a0[4], a1[4];
#pragma unroll
                for (int j = 0; j < 4; ++j) { a0[j] = (f32x4){0.f, 0.f, 0.f, 0.f}; a1[j] = (f32x4){0.f, 0.f, 0.f, 0.f}; }
#pragma unroll 2
                for (int n2 = 0; n2 < 16; ++n2) {
                    const u32x4 wr_ = *(const u32x4*)(Y1 + ((size_t)n2 * 1024 + k1) * 512 + 8 * lane), wi_ = *(const u32x4*)(Y1 + ((size_t)n2 * 1024 + 512 + k1) * 512 + 8 * lane);
                    const f32x4 r0 = {bf_lo(wr_.x), bf_hi(wr_.x), bf_lo(wr_.y), bf_hi(wr_.y)}, r1 = {bf_lo(wr_.z), bf_hi(wr_.z), bf_lo(wr_.w), bf_hi(wr_.w)};
                    const f32x4 i0 = {bf_lo(wi_.x), bf_hi(wi_.x), bf_lo(wi_.y), bf_hi(wi_.y)}, i1 = {bf_lo(wi_.z), bf_hi(wi_.z), bf_lo(wi_.w), bf_hi(wi_.w)};
#pragma unroll
                    for (int j = 0; j < 4; ++j) { const int kk = k1 + 512 * (4 * qf + j); const float ph = (float)((n2 * kk) & 8191) * (1.0f / 8192.0f);
                        const float cs = __builtin_amdgcn_cosf(ph), sn = __builtin_amdgcn_sinf(ph);
                        a0[j] += r0 * cs + i0 * sn; a1[j] += r1 * cs + i1 * sn; }
                }
#pragma unroll
                for (int j = 0; j < 4; ++j) { const int kk = k1 + 512 * (4 * qf + j);
                    u32x4 w; w.x = pk2(a0[j].x, a0[j].y); w.y = pk2(a0[j].z, a0[j].w); w.z = pk2(a1[j].x, a1[j].y); w.w = pk2(a1[j].z, a1[j].w);
                    *(u32x4*)(Y + (size_t)kk * DM + 1536 + 8 * lane) = w; }
            }
            if (l == 0) {
                for (int idx = vcu * NTHREADS + tid; idx < NCTX * 512; idx += G * NTHREADS) {
                    const int k = idx >> 9, d = idx & 511; const u32x4* a = (const u32x4*)(DFTC + (size_t)k * 512); const u32x4* b = (const u32x4*)(ZWTC + (size_t)d * 512);
                    float s = 0.f;
#pragma unroll 16
                    for (int i = 0; i < 64; ++i) { const u32x4 wa = a[i], wb = b[i];
                        s += bf_lo(wa.x) * bf_lo(wb.x) + bf_hi(wa.x) * bf_hi(wb.x) + bf_lo(wa.y) * bf_lo(wb.y) + bf_hi(wa.y) * bf_hi(wb.y)
                           + bf_lo(wa.z) * bf_lo(wb.z) + bf_hi(wa.z) * bf_hi(wb.z) + bf_lo(wa.w) * bf_lo(wb.w) + bf_hi(wa.w) * bf_hi(wb.w); }
                    Y[(size_t)(NLAT + k) * DM + 1536 + d] = (bf16_t)(pk2(s, 0.f) & 0xffffu);
                }
            }
        }
        SEAM(PB + 3);

        if (IN(PB + 4)) for (int rep_ = 0; rep_ < REP_K4; ++rep_) {
            pg8::Gemm g{Y, WOUTl, DM, DM, DM}; pg8::SchedTiles S{32, 8, 256, G, bx, DM, DM, 256};
            pg8::EpiBf16 E{O, DM, O, DM};
#ifndef NO_G4
            pg8::gemm_phase<pg8::EpiBf16, pg8::SchedTiles, true>(L, g, S, E);
#endif
            if (l == 0) { PHASE_LOCALS
                pg8::ctx_gemm<0>(Y + (size_t)NLAT * DM, DM, WOUTl, DM, DM, 32, 0, O + (size_t)NLAT * DM, DM, 0, L, tid, vcu, G);
            }
        }
        SEAM(PB + 4);

        if (IN(PB + 5)) {
            PHASE_LOCALS
            LAS float* vv = (LAS float*)L;
            LAS float* wr = vv + 6 * DM;
            LAS int* lcnt = (LAS int*)(L + LDSCTL_OFF + 2048);
            __syncthreads();
            for (int i = tid; i < 2 * DM; i += NTHREADS) { const int v = i >> 11, c = i & (DM - 1);
                vv[(v * 3 + 0) * DM + c] = modp(ws, l, v, 2)[c] * g_post_mix[l * DM + c];
                vv[(v * 3 + 1) * DM + c] = g_pre_ffn[l * DM + c] * (1.0f + modp(ws, l, v, 4)[c]);
                vv[(v * 3 + 2) * DM + c] = modp(ws, l, v, 3)[c]; }
            if (l == 1) { for (int i = tid; i < DM * 8 / 4; i += NTHREADS) ((LAS f32x4*)wr)[i] = ((const f32x4*)w_router)[i]; if (tid < 8) lcnt[tid] = 0; }
            __syncthreads();
            for (int rep5_ = 0; rep5_ < (l == 0 ? REP_K5 : 1); ++rep5_)
            for (int row = gw; row < nrows; row += NGW) {
                const int v = row >= NLAT;
                const float* xs = l == 0 ? (v ? ctx_in + (size_t)(row - NLAT) * DM : x_in + (size_t)row * DM) : X + (size_t)row * DM;
                f32x4 ov[8], xv[8]; ld_row_bf16(O + (size_t)row * DM, lane, ov); ld_row_f32_nt(xs, lane, xv);
                const float r1 = __builtin_amdgcn_rsqf(row_sumsq(ov) * (1.0f / DM) + EPS);
                const LAS f32x4* GG = (const LAS f32x4*)(vv + (v * 3 + 0) * DM) + lane; const LAS f32x4* A2 = (const LAS f32x4*)(vv + (v * 3 + 1) * DM) + lane; const LAS f32x4* B2 = (const LAS f32x4*)(vv + (v * 3 + 2) * DM) + lane;
#pragma unroll
                for (int j = 0; j < 8; ++j) xv[j] = xv[j] + ov[j] * r1 * GG[64 * j];
                st_row_f32_nt(X + (size_t)row * DM, lane, xv);
                const float r2 = __builtin_amdgcn_rsqf(row_sumsq(xv) * (1.0f / DM) + EPS);
#pragma unroll
                for (int j = 0; j < 8; ++j) xv[j] = xv[j] * r2 * A2[64 * j] + B2[64 * j];
                st_row_bf16(H + (size_t)row * DM, lane, xv);
                if (l == 1) {
                    float lg[8];
#pragma unroll
                    for (int e = 0; e < 8; ++e) lg[e] = 0.f;
#pragma unroll
                    for (int j = 0; j < 8; ++j)
#pragma unroll
                        for (int i = 0; i < 4; ++i) { const int col = 4 * lane + 256 * j + i; const f32x4 w0 = *(const LAS f32x4*)(wr + col * 8), w1 = *(const LAS f32x4*)(wr + col * 8 + 4); const float hv = xv[j][i];
                            lg[0] += hv * w0.x; lg[1] += hv * w0.y; lg[2] += hv * w0.z; lg[3] += hv * w0.w; lg[4] += hv * w1.x; lg[5] += hv * w1.y; lg[6] += hv * w1.z; lg[7] += hv * w1.w; }
#pragma unroll
                    for (int e = 0; e < 8; ++e) lg[e] = wave_sum(lg[e]);
                    int i0 = 0; float m0 = lg[0];
#pragma unroll
                    for (int e = 1; e < 8; ++e) if (lg[e] > m0) { m0 = lg[e]; i0 = e; }
                    int i1 = -1; float m1 = -INFINITY;
#pragma unroll
                    for (int e = 0; e < 8; ++e) if (e != i0 && lg[e] > m1) { m1 = lg[e]; i1 = e; }
                    const float ex = __expf(m1 - m0); const float w0 = 1.0f / (1.0f + ex), w1 = ex / (1.0f + ex);
                    if (lane == 0) { const int r0 = __hip_atomic_fetch_add(&lcnt[i0], 1, __ATOMIC_RELAXED, __HIP_MEMORY_SCOPE_WORKGROUP), r1_ = __hip_atomic_fetch_add(&lcnt[i1], 1, __ATOMIC_RELAXED, __HIP_MEMORY_SCOPE_WORKGROUP);
                        u32x4 ta; ta.x = (unsigned)i0; ta.y = (unsigned)i1; ta.z = (unsigned)r0; ta.w = (unsigned)r1_; *(u32x4*)(TOK + (size_t)row * 8) = ta;
                        TOK[(size_t)row * 8 + 4] = __float_as_uint(w0); TOK[(size_t)row * 8 + 5] = __float_as_uint(w1); }
                }
            }
            if (l == 1) { __syncthreads(); if (tid < 8) WGCNT[vcu * 8 + tid] = lcnt[tid]; }
        }
        SEAM(PB + 5);

        if (l == 1) {
            if (IN(PB + 6)) {
                PHASE_LOCALS
                moe_tables(ws, L + LDSCTL_OFF, L, true, G);
                const LAS int* T = (const LAS int*)(L + LDSCTL_OFF);
                for (int row = gw; row < NLAT; row += NGW) {
                    const u32x4 ta = *(const u32x4*)(TOK + (size_t)row * 8);
                    const int p0 = T[256 + vcu * 8 + (int)ta.x] + (int)ta.z, p1 = T[256 + vcu * 8 + (int)ta.y] + (int)ta.w;
                    if (lane == 0) { TOK[(size_t)row * 8 + 6] = (unsigned)p0; TOK[(size_t)row * 8 + 7] = (unsigned)p1; }
                    const u32x4* src = (const u32x4*)(H + (size_t)row * DM); u32x4* d0 = (u32x4*)(HS + (size_t)p0 * DM); u32x4* d1 = (u32x4*)(HS + (size_t)p1 * DM);
#pragma unroll
                    for (int j = 0; j < 4; ++j) { const u32x4 w = __builtin_nontemporal_load(src + lane + 64 * j); d0[lane + 64 * j] = w; d1[lane + 64 * j] = w; }
                }
                for (int e = 0; e < 8; ++e) { const int st = T[e] + T[16 + e], en = T[e + 1];
                    for (int r = st + gw; r < en; r += NGW) { u32x4* d0 = (u32x4*)(HS + (size_t)r * DM);
#pragma unroll
                        for (int j = 0; j < 4; ++j) d0[lane + 64 * j] = (u32x4){0u, 0u, 0u, 0u}; } }
            }
            SEAM(PB + 6);
        }

        if (IN(PB + 7) || IN(PB + 8)) {
            PHASE_LOCALS
            LAS int* T = (LAS int*)(L + LDSCTL_OFF);
            if (l == 0) { __syncthreads(); if (tid < 72) T[64 + tid] = 0; if (tid == 0) T[32] = NLAT / 256; __syncthreads(); }
            else moe_tables(ws, L + LDSCTL_OFF, L, false, G);
        }
        if (IN(PB + 7)) for (int rep_ = 0; rep_ < REP_K7; ++rep_) {
            const LAS int* T = (const LAS int*)(L + LDSCTL_OFF);
            pg8::Gemm g{l == 0 ? H : HS, l == 0 ? WGU : MGU, DM, DM, DM};
            const int units7 = T[32] * 56, left7 = units7 - (units7 / G) * G; const bool wide7 = l == 1 && left7 > 0 && left7 <= WIDE_MAX;
            pg8::SchedMoe S{T[32], 56, G, bx, DM, DM, 128, (long)2 * DFF * DM, T + 64, wide7 ? units7 - left7 : 1 << 30};
            pg8::EpiSwiglu E{l == 0 ? ACT : MACT, DFF};
#ifndef NO_G7
            pg8::gemm_phase<pg8::EpiSwiglu, pg8::SchedMoe, true>(L, g, S, E);
#endif
            { PHASE_LOCALS
              if (l == 0) pg8::ctx_gemm_wide<1>(H + (size_t)NLAT * DM, DM, WGU, DM, DM, 224, 1, ACT + (size_t)NLAT * DFF, DFF, L, tid, vcu, G);
              else if (wide7) pg8::ctx_gemm_wide<1>(HS, DM, MGU, DM, DM, 0, 0, MACT, DFF, L, tid, vcu, G, T + 64, T[32], units7 - left7, (long)2 * DFF * DM, left7);
            }
        }
        SEAM(PB + 7);
        if (IN(PB + 8)) for (int rep_ = 0; rep_ < REP_K8; ++rep_) {
            const LAS int* T = (const LAS int*)(L + LDSCTL_OFF);
            pg8::Gemm g{l == 0 ? ACT : MACT, l == 0 ? WDN : MDN, DFF, DFF, DFF};
            const int dn_first = 2 * G;
            pg8::SchedMoe S{T[32], 8, G, bx, DFF, DFF, 256, (long)DM * DFF, T + 64, dn_first};
            pg8::EpiBf16 E{l == 0 ? O : DOUT, DM, O, DM};
#ifndef NO_G8
            pg8::gemm_phase<pg8::EpiBf16, pg8::SchedMoe, true>(L, g, S, E);
#endif
            if (l == 1 && T[32] * 8 > dn_first) {
                const int R = T[32] * 8 - dn_first;
                const int nsl = 14 * R <= G ? 14 : 8 * R <= G ? 8 : 7 * R <= G ? 7 : 4;
                if (threadIdx.x == 0) for (int Lt = bx; Lt < nsl * R; Lt += G) if (Lt % nsl == 0) { int p_, pn_; pg8::moe_map(dn_first + Lt / nsl, T[32], 8, p_, pn_); ctl[CW_TAIL + p_ * 8 + pn_] = ((unsigned)(Lt / nsl) + 1u) | ((unsigned)nsl << 16); }
                pg8::Gemm g2{MACT, MDN, DFF, DFF, DFF / nsl}; pg8::SchedMoeTail S2{T[32], 8, G, bx, DFF, DFF, (long)DM * DFF, T + 64, dn_first, DFF / nsl, nsl};
                pg8::EpiF32 E2{(float*)(ws + WS_PART), 256};
                pg8::gemm_phase<pg8::EpiF32, pg8::SchedMoeTail, true>(L, g2, S2, E2);
            }
            if (l == 0) { PHASE_LOCALS
                pg8::ctx_gemm_wide<3>(ACT + (size_t)NLAT * DFF, DFF, WDN, DFF, DFF / 7, 32, 7, ws + WS_PART, DM, L, tid, vcu, G);
            }
        }
        SEAM(PB + 8);

        if (IN(PB + 9)) {
            PHASE_LOCALS
            LAS float* vv = (LAS float*)L;
            __syncthreads();
            for (int i = tid; i < 2 * DM; i += NTHREADS) { const int v = i >> 11, c = i & (DM - 1);
                vv[(v * 3 + 0) * DM + c] = modp(ws, l, v, 5)[c] * g_post_ffn[l * DM + c];
                if (l == 0) { vv[(v * 3 + 1) * DM + c] = g_pre_mix[DM + c] * (1.0f + modp(ws, 1, v, 1)[c]); vv[(v * 3 + 2) * DM + c] = modp(ws, 1, v, 0)[c]; } }
            __syncthreads();
            for (int row = gw; row < nrows; row += NGW) {
                const int v = row >= NLAT;
                f32x4 ov[8], xv[8];
                if (l == 0) {
                    if (v) { const float* cp = (const float*)(ws + WS_PART) + (size_t)(row - NLAT) * DM;
                        ld_row_f32(cp, lane, ov);
                        for (int ks = 1; ks < 7; ++ks) { f32x4 t_[8]; ld_row_f32(cp + (size_t)ks * NCTX * DM, lane, t_);
#pragma unroll
                            for (int j = 0; j < 8; ++j) ov[j] += t_[j]; } }
                    else ld_row_bf16(O + (size_t)row * DM, lane, ov); }
                else { const unsigned p0 = TOK[(size_t)row * 8 + 6], p1 = TOK[(size_t)row * 8 + 7]; const float w0 = __uint_as_float(TOK[(size_t)row * 8 + 4]), w1 = __uint_as_float(TOK[(size_t)row * 8 + 5]);
                    f32x4 o1[8]; ld_row_bf16(DOUT + (size_t)p0 * DM, lane, ov); ld_row_bf16(DOUT + (size_t)p1 * DM, lane, o1);
                    const float* PART = (const float*)(ws + WS_PART);
                    const u32x4* tf0 = (const u32x4*)(ctl + CW_TAIL + (p0 >> 8) * 8); const u32x4* tf1 = (const u32x4*)(ctl + CW_TAIL + (p1 >> 8) * 8);
                    const u32x4 f0a = tf0[0], f0b = tf0[1], f1a = tf1[0], f1b = tf1[1];
                    if ((f0a.x | f0a.y | f0a.z | f0a.w | f0b.x | f0b.y | f0b.z | f0b.w | f1a.x | f1a.y | f1a.z | f1a.w | f1b.x | f1b.y | f1b.z | f1b.w) != 0u) {
#pragma unroll
                        for (int j = 0; j < 8; ++j) {
                            const unsigned t0 = __builtin_amdgcn_readfirstlane(j < 4 ? f0a[j & 3] : f0b[j & 3]), t1 = __builtin_amdgcn_readfirstlane(j < 4 ? f1a[j & 3] : f1b[j & 3]);
                            if (t0) { const int ns_ = (int)(t0 >> 16), ub_ = (int)((t0 & 0xffffu) - 1u) * ns_; f32x4 a = {0.f, 0.f, 0.f, 0.f}; for (int ks = 0; ks < ns_; ++ks) a += *(const f32x4*)(PART + ((size_t)(ub_ + ks) * 256 + (p0 & 255)) * 256 + 4 * lane); ov[j] = a; }
                            if (t1) { const int ns_ = (int)(t1 >> 16), ub_ = (int)((t1 & 0xffffu) - 1u) * ns_; f32x4 a = {0.f, 0.f, 0.f, 0.f}; for (int ks = 0; ks < ns_; ++ks) a += *(const f32x4*)(PART + ((size_t)(ub_ + ks) * 256 + (p1 & 255)) * 256 + 4 * lane); o1[j] = a; }
                        }
                    }
#pragma unroll
                    for (int j = 0; j < 8; ++j) ov[j] = ov[j] * w0 + o1[j] * w1; }
                ld_row_f32_nt(X + (size_t)row * DM, lane, xv);
                const float r1 = __builtin_amdgcn_rsqf(row_sumsq(ov) * (1.0f / DM) + EPS);
                const LAS f32x4* GG = (const LAS f32x4*)(vv + (v * 3 + 0) * DM) + lane;
#pragma unroll
                for (int j = 0; j < 8; ++j) xv[j] = xv[j] + ov[j] * r1 * GG[64 * j];
                if (l == 0) {
                    st_row_f32_nt(X + (size_t)row * DM, lane, xv);
                    const LAS f32x4* A2 = (const LAS f32x4*)(vv + (v * 3 + 1) * DM) + lane; const LAS f32x4* B2 = (const LAS f32x4*)(vv + (v * 3 + 2) * DM) + lane;
                    const float r2 = __builtin_amdgcn_rsqf(row_sumsq(xv) * (1.0f / DM) + EPS);
#pragma unroll
                    for (int j = 0; j < 8; ++j) xv[j] = xv[j] * r2 * A2[64 * j] + B2[64 * j];
                    st_row_bf16(H + (size_t)row * DM, lane, xv);
                } else st_row_f32_nt(args.out + (size_t)row * DM, lane, xv);
            }
        }
        if (l == 0) SEAM(PB + 9);
    }
#undef IN
#undef SEAM
}

extern "C" void kernel_launch(void* const* d_in, const int* in_sizes, int n_in, void* d_out, int out_size, void* d_ws, size_t ws_size, hipStream_t stream) {
    static int grid = 0;
    if (grid == 0) {
        if (n_in != 27 || out_size != NLAT * DM || ws_size < WS_END) { fprintf(stderr, "kernel_launch: unexpected shapes (n_in %d out %d ws %zu)\n", n_in, out_size, ws_size); grid = -1; return; }
        int dev = 0, cus = 0, per_cu = 0;
        if (hipGetDevice(&dev) != hipSuccess || hipDeviceGetAttribute(&cus, hipDeviceAttributeMultiprocessorCount, dev) != hipSuccess) { grid = -1; return; }
        if (hipFuncSetAttribute((const void*)fwd_kernel, hipFuncAttributeMaxDynamicSharedMemorySize, LDS_BYTES) != hipSuccess) { fprintf(stderr, "kernel_launch: hipFuncSetAttribute failed\n"); grid = -1; return; }
        if (hipOccupancyMaxActiveBlocksPerMultiprocessor(&per_cu, (const void*)fwd_kernel, NTHREADS, LDS_BYTES) != hipSuccess || per_cu < 1) { fprintf(stderr, "kernel_launch: occupancy query says %d\n", per_cu); (void)hipGetLastError(); per_cu = 1; }
        grid = cus > 256 ? 256 : cus;
    }
    if (grid < 0) return;
    (void)hipMemsetAsync((char*)d_ws + WS_CTL, 0, CTL_ZERO_BYTES, stream);
    Args a{};
    for (int i = 0; i < 27; ++i) a.in[i] = (const float*)d_in[i];
    a.out = (float*)d_out; a.ws = (unsigned char*)d_ws; a.ph_lo = 0; a.ph_hi = 1000;
    hipLaunchKernelGGL(fwd_kernel, dim3(grid), dim3(NTHREADS), LDS_BYTES, stream, a);
}
```
